# Optimizing an MI355X kernel written in HIP

```python
import jax, jax.numpy as jnp
from jax import lax
import numpy as np

D_MODEL = 1024
BATCH = 32
SEQ = 2048
DEPTH = 2

MEM_LEN = 256
D_MIX = 2 * D_MODEL
HG_DK = 128
HG_DV = 128
HG_WIDTH = 3 * D_MODEL // 4
HG_HEADS = HG_WIDTH // HG_DK
HG_CHUNK = 32
ML_WIDTH = 3 * D_MODEL // 4
ML_HEADS = 4
ML_DH = ML_WIDTH // ML_HEADS
ML_BLOCK = 4
ML_NBLK = ML_WIDTH // ML_BLOCK
ML_CONV = 4
ML_CHUNK = 64
XA_WIDTH = D_MODEL // 2
XA_HEADS = 4
XA_DH = XA_WIDTH // XA_HEADS

P_IN = 4 * HG_WIDTH + 2 * ML_WIDTH + 2 * XA_WIDTH
SPLITS = tuple(np.cumsum([HG_WIDTH] * 4 + [ML_WIDTH] * 2 + [XA_WIDTH] * 2)[:-1].tolist())
EPS = 1e-6
M_INIT = -1e30

kernel_name = "hymba_hgrn2_mlstm_memxattn"


def rms_norm(x, w):
    xf = x.astype(jnp.float32)
    y = xf * lax.rsqrt(jnp.mean(xf * xf, axis=-1, keepdims=True) + EPS)
    return (y * w.astype(jnp.float32)).astype(x.dtype)


def split_heads(t, h):
    b, s, _ = t.shape
    return t.reshape(b, s, h, -1).transpose(0, 2, 1, 3)


def merge_heads(t):
    b, h, s, d = t.shape
    return t.transpose(0, 2, 1, 3).reshape(b, s, h * d)


def to_chunks(t, c):
    b, h, s = t.shape[:3]
    return jnp.moveaxis(t.reshape(b, h, s // c, c, *t.shape[3:]), 2, 0)


def from_chunks(t):
    t = jnp.moveaxis(t, 0, 2)
    return t.reshape(t.shape[0], t.shape[1], -1, t.shape[-1])


def head_rms(t, h, w):
    b, s, _ = t.shape
    th = t.astype(jnp.float32).reshape(b, s, h, -1)
    th = th * lax.rsqrt(jnp.mean(th * th, axis=-1, keepdims=True) + EPS) * w.astype(jnp.float32)
    return th.reshape(b, s, -1)


def causal_conv(x, w, bias):
    k, c = w.shape
    y = lax.conv_general_dilated(x, w[:, None, :], window_strides=(1,), padding=[(k - 1, 0)],
                                 dimension_numbers=('NWC', 'WIO', 'NWC'), feature_group_count=c)
    return y + bias


def headwise(x, w):
    b, s, _ = x.shape
    y = jnp.einsum('btgi,gio->btgo', x.reshape(b, s, ML_NBLK, ML_BLOCK), w)
    return y.reshape(b, s, ML_WIDTH)


def hgrn2_mixer(q, f_pre, i, lb):
    f32 = jnp.float32
    bsz = q.shape[0]
    q = jax.nn.silu(q.astype(f32)) * HG_DK ** -0.5
    f_pre = f_pre.astype(f32)
    lb = lb.astype(f32)
    log_f = jnp.logaddexp(jnp.log(lb), jnp.log1p(-lb) + jax.nn.log_sigmoid(f_pre))
    k = (1.0 - lb) * jax.nn.sigmoid(-f_pre)
    v = i.astype(f32)
    qc, kc, gc = (to_chunks(split_heads(t, HG_HEADS), HG_CHUNK) for t in (q, k, log_f))
    vc = to_chunks(split_heads(v, HG_HEADS), HG_CHUNK)
    causal = jnp.tril(jnp.ones((HG_CHUNK, HG_CHUNK), dtype=bool))

    def step(S, xs):
        qb, kb, vb, gb = xs
        bcum = jnp.cumsum(gb, axis=2)
        dec = bcum[:, :, :, None, :] - bcum[:, :, None, :, :]
        dec = jnp.exp(jnp.where(causal[:, :, None], dec, -jnp.inf))
        A = jnp.einsum('bhtd,bhsd,bhtsd->bhts', qb, kb, dec)
        o = (jnp.einsum('bhts,bhsv->bhtv', A, vb)
             + jnp.einsum('bhtd,bhdv->bhtv', qb * jnp.exp(bcum), S))
        blast = bcum[:, :, -1:, :]
        S = (jnp.exp(blast[:, :, 0, :, None]) * S
             + jnp.einsum('bhsd,bhsv->bhdv', kb * jnp.exp(blast - bcum), vb))
        return S, o

    S0 = jnp.zeros((bsz, HG_HEADS, HG_DK, HG_DV), f32)
    _, o = lax.scan(step, S0, (qc, kc, vc, gc))
    return merge_heads(from_chunks(o))


def mlstm_mixer(xm, conv_w, conv_b, wq, wk, wv, w_gate, b_gate, norm_w, skip):
    f32 = jnp.float32
    bsz = xm.shape[0]
    xc = jax.nn.silu(causal_conv(xm, conv_w, conv_b))
    q = headwise(xc, wq)
    k = headwise(xc, wk)
    v = headwise(xm, wv)
    gates = (jnp.concatenate([q, k, v], axis=-1) @ w_gate + b_gate).astype(f32)
    i_pre = gates[..., :ML_HEADS].transpose(0, 2, 1)
    log_f = jax.nn.log_sigmoid(gates[..., ML_HEADS:]).transpose(0, 2, 1)
    qh = split_heads(q.astype(f32), ML_HEADS)
    kh = split_heads(k.astype(f32), ML_HEADS) * ML_DH ** -0.5
    vh = split_heads(v.astype(f32), ML_HEADS)
    qc, kc, vc = (to_chunks(t, ML_CHUNK) for t in (qh, kh, vh))
    ic, fc = (to_chunks(t, ML_CHUNK) for t in (i_pre, log_f))
    causal = jnp.tril(jnp.ones((ML_CHUNK, ML_CHUNK), dtype=bool))

    def step(carry, xs):
        Cm, n, m = carry
        qb, kb, vb, ib, fb = xs
        bcum = jnp.cumsum(fb, axis=-1)
        D = jnp.where(causal, bcum[..., :, None] - bcum[..., None, :] + ib[..., None, :], -jnp.inf)
        inter = bcum + m[..., None]
        m_t = jnp.maximum(inter, jnp.max(D, axis=-1))
        w_intra = jnp.exp(D - m_t[..., None])
        w_inter = jnp.exp(inter - m_t)
        Sm = jnp.einsum('bhtd,bhsd->bhts', qb, kb) * w_intra
        num = (jnp.einsum('bhts,bhsv->bhtv', Sm, vb)
               + w_inter[..., None] * jnp.einsum('bhtd,bhdv->bhtv', qb, Cm))
        den = jnp.sum(Sm, axis=-1) + w_inter * jnp.einsum('bhtd,bhd->bht', qb, n)
        h = num / jnp.maximum(jnp.abs(den), jnp.exp(-m_t))[..., None]
        blast = bcum[..., -1]
        g_s = blast[..., None] - bcum + ib
        m_new = jnp.maximum(blast + m, jnp.max(g_s, axis=-1))
        w_old = jnp.exp(blast + m - m_new)
        kw = kb * jnp.exp(g_s - m_new[..., None])[..., None]
        Cm = w_old[..., None, None] * Cm + jnp.einsum('bhsd,bhsv->bhdv', kw, vb)
        n = w_old[..., None] * n + jnp.sum(kw, axis=2)
        return (Cm, n, m_new), h

    init = (jnp.zeros((bsz, ML_HEADS, ML_DH, ML_DH), f32),
            jnp.zeros((bsz, ML_HEADS, ML_DH), f32),
            jnp.full((bsz, ML_HEADS), M_INIT, f32))
    _, h = lax.scan(step, init, (qc, kc, vc, ic, fc))
    h = from_chunks(h)
    mu = jnp.mean(h, axis=-1, keepdims=True)
    var = jnp.mean(jnp.square(h - mu), axis=-1, keepdims=True)
    h = merge_heads((h - mu) * lax.rsqrt(var + EPS))
    return h * norm_w.astype(f32) + skip.astype(f32) * xc.astype(f32)


def memory_xattn(q, mem_k, mem_v):
    bsz, s, _ = q.shape
    qh = q.reshape(bsz, s, XA_HEADS, XA_DH)
    kh = mem_k.reshape(bsz, MEM_LEN, XA_HEADS, XA_DH)
    vh = mem_v.reshape(bsz, MEM_LEN, XA_HEADS, XA_DH)
    scores = jnp.einsum('bthd,bmhd->bhtm', qh, kh).astype(jnp.float32) * XA_DH ** -0.5
    p = jax.nn.softmax(scores, axis=-1)
    o = jnp.einsum('bhtm,bmhd->bthd', p, vh.astype(jnp.float32))
    return o.reshape(bsz, s, XA_WIDTH)


def setup_inputs(seed: int = 0) -> dict:
    key = jax.random.key(seed)
    ks = jax.random.split(key, 24)
    nrm = lambda k, shape, s: jax.random.normal(k, shape, jnp.float32) * s
    f_bias = jnp.linspace(3.0, 6.0, ML_HEADS, dtype=jnp.float32)[None, :] + nrm(ks[13], (DEPTH, ML_HEADS), 0.05)
    return {
        "x": nrm(ks[0], (BATCH, SEQ, D_MODEL), 1.0),
        "mem": nrm(ks[1], (BATCH, MEM_LEN, D_MODEL), 1.0),
        "norm_w": 1.0 + nrm(ks[2], (DEPTH, D_MODEL), 0.02),
        "w_in": nrm(ks[3], (DEPTH, D_MODEL, P_IN), D_MODEL ** -0.5),
        "hgrn_lb_logits": nrm(ks[4], (DEPTH, HG_WIDTH), 0.1),
        "hgrn_norm_w": 1.0 + nrm(ks[5], (DEPTH, HG_DV), 0.02),
        "mlstm_conv_w": nrm(ks[6], (DEPTH, ML_CONV, ML_WIDTH), ML_CONV ** -0.5),
        "mlstm_conv_b": nrm(ks[7], (DEPTH, ML_WIDTH), 0.02),
        "mlstm_wq": nrm(ks[8], (DEPTH, ML_NBLK, ML_BLOCK, ML_BLOCK), ML_BLOCK ** -0.5),
        "mlstm_wk": nrm(ks[9], (DEPTH, ML_NBLK, ML_BLOCK, ML_BLOCK), ML_BLOCK ** -0.5),
        "mlstm_wv": nrm(ks[10], (DEPTH, ML_NBLK, ML_BLOCK, ML_BLOCK), ML_BLOCK ** -0.5),
        "mlstm_w_gate": nrm(ks[11], (DEPTH, 3 * ML_WIDTH, 2 * ML_HEADS), 0.3 * (3 * ML_WIDTH) ** -0.5),
        "mlstm_b_gate": jnp.concatenate([nrm(ks[12], (DEPTH, ML_HEADS), 0.1), f_bias], axis=-1),
        "mlstm_norm_w": 1.0 + nrm(ks[14], (DEPTH, ML_WIDTH), 0.02),
        "mlstm_skip": 1.0 + nrm(ks[15], (DEPTH, ML_WIDTH), 0.02),
        "mem_norm_w": 1.0 + nrm(ks[16], (DEPTH, D_MODEL), 0.02),
        "w_kv_mem": nrm(ks[17], (DEPTH, D_MODEL, 2 * XA_WIDTH), D_MODEL ** -0.5),
        "xattn_norm_w": 1.0 + nrm(ks[18], (DEPTH, XA_DH), 0.02),
        "w_out": nrm(ks[19], (DEPTH, D_MIX, D_MODEL), D_MIX ** -0.5),
        "final_norm_w": 1.0 + nrm(ks[20], (D_MODEL,), 0.02),
    }


def reference(x, mem, norm_w, w_in, hgrn_lb_logits, hgrn_norm_w, mlstm_conv_w, mlstm_conv_b,
              mlstm_wq, mlstm_wk, mlstm_wv, mlstm_w_gate, mlstm_b_gate, mlstm_norm_w, mlstm_skip,
              mem_norm_w, w_kv_mem, xattn_norm_w, w_out, final_norm_w):
    dt = x.dtype
    lb_all = jnp.cumsum(jax.nn.softmax(hgrn_lb_logits.astype(jnp.float32), axis=0), axis=0)
    lb_all = jnp.maximum(lb_all - lb_all[0:1], 0.0)
    for l in range(DEPTH):
        h = rms_norm(x, norm_w[l])
        proj = h @ w_in[l]
        hq, hf, hi, hg, mx, mz, aq, az = jnp.split(proj, SPLITS, axis=-1)
        o_hg = head_rms(hgrn2_mixer(hq, hf, hi, lb_all[l]), HG_HEADS, hgrn_norm_w[l]) * jax.nn.silu(hg)
        o_ml = mlstm_mixer(mx, mlstm_conv_w[l], mlstm_conv_b[l], mlstm_wq[l], mlstm_wk[l], mlstm_wv[l],
                           mlstm_w_gate[l], mlstm_b_gate[l], mlstm_norm_w[l], mlstm_skip[l]) * jax.nn.silu(mz)
        mkv = rms_norm(mem, mem_norm_w[l]) @ w_kv_mem[l]
        mk, mv = jnp.split(mkv, 2, axis=-1)
        o_xa = head_rms(memory_xattn(aq, mk, mv), XA_HEADS, xattn_norm_w[l]) * jax.nn.silu(az)
        y = jnp.concatenate([o_hg, o_ml, o_xa], axis=-1).astype(dt) @ w_out[l]
        x = x + y
    return rms_norm(x, final_norm_w)
```

```cpp
#include <hip/hip_runtime.h>
#include <hip/hip_cooperative_groups.h>
#include <hip/hip_bf16.h>
#include <cstdio>
#include <cstdint>
namespace cg = cooperative_groups;

#ifndef MK_SINGLE
#define MK_SINGLE 0
#endif

#define LAS __attribute__((address_space(3)))
typedef unsigned short bf16_t;
typedef short bf16x8 __attribute__((ext_vector_type(8)));
typedef float f32x4 __attribute__((ext_vector_type(4)));
typedef unsigned u32x4 __attribute__((ext_vector_type(4)));
typedef unsigned u32x2 __attribute__((ext_vector_type(2)));

constexpr int D_MODEL = 1024, BATCH = 32, SEQ = 2048, DEPTH = 2, MEM_LEN = 256, D_MIX = 2048;
constexpr int M_TOK = BATCH * SEQ;
constexpr int M_MEM = BATCH * MEM_LEN;
constexpr int P_IN = 5632;
constexpr float EPS = 1e-6f;
constexpr int O_HG = 0, O_MZ = 768, O_AZ = 1536, O_HQ = 2048, O_HF = 2816, O_HI = 3584, O_MX = 4352, O_AQ = 5120;
__host__ __device__ __forceinline__ int src_col(int n) {
    if (n < 768) return 2304 + n;
    if (n < 1536) return 3840 + (n - 768);
    if (n < 2048) return 5120 + (n - 1536);
    if (n < 2816) return n - 2048;
    if (n < 3584) return 768 + (n - 2816);
    if (n < 4352) return 1536 + (n - 3584);
    if (n < 5120) return 3072 + (n - 4352);
    return 4608 + (n - 5120);
}

constexpr size_t MiB = 1u << 20;
constexpr size_t WS_CTL = 0, CTL_ZERO_BYTES = 64 * 1024;
constexpr size_t WS_WIN = 2 * MiB;
constexpr size_t WS_WKV = 24 * MiB;
constexpr size_t WS_WOUT = 28 * MiB;
constexpr size_t WS_SS0 = 36 * MiB;
constexpr size_t WS_SS1 = WS_SS0 + 256 * 1024;
constexpr size_t WS_SS2 = WS_SS1 + 256 * 1024;
constexpr size_t WS_SSM = WS_SS2 + 256 * 1024;
constexpr size_t WS_LB = WS_SSM + 64 * 1024;
constexpr size_t WS_GATES = 38 * MiB;
constexpr size_t WS_MEMB = 40 * MiB;
constexpr size_t WS_MKV = 56 * MiB;
constexpr size_t WS_XB = 88 * MiB;
constexpr size_t WS_PROJ = 216 * MiB;
constexpr size_t WS_END = 920 * MiB;
constexpr int CW_QUEUE = 1024;

constexpr int RING_BYTES = 131072;
constexpr int MISC_OFF = RING_BYTES + 256;
constexpr int LDS_BYTES = 147456;

__device__ __forceinline__ float bf2f(bf16_t v) { return __uint_as_float((unsigned)v << 16); }
__device__ __forceinline__ unsigned f2bf(float f) { unsigned u = __float_as_uint(f); return (u + 0x7fffu + ((u >> 16) & 1u)) >> 16; }
__device__ __forceinline__ unsigned pk2(float lo, float hi) { return f2bf(lo) | (f2bf(hi) << 16); }
__device__ __forceinline__ float silu_f(float x) { return x / (1.f + __expf(-x)); }
__device__ __forceinline__ float wave_sum(float v) {
#pragma unroll
    for (int o = 1; o < 64; o <<= 1) v += __shfl_xor(v, o);
    return v;
}

namespace pg8 {
constexpr int BM = 256, BK = 64, HALF = 128, HTB = HALF * BK * 2, STAGE_BYTES = 8 * HTB, NXCD = 8, WGM = 8;
__host__ __device__ __forceinline__ int lds_byte(int r, int c) { const int st = (r >> 4) * 2 + (c >> 5), rr = r & 15, cc = c & 31, ob = rr * 64 + cc * 2; return st * 1024 + (ob ^ (((ob >> 9) & 1) << 5)); }
__host__ __device__ __forceinline__ void stage_rc(int b, int& R, int& C) { const int st = b / 1024, sb = b % 1024, swz = sb ^ (((sb >> 9) & 1) << 5); R = (st >> 1) * 16 + swz / 64; C = (st & 1) * 32 + (swz % 64) / 2; }
__host__ __device__ __forceinline__ int perm32(int rho) { const int n = rho >> 4, i = rho & 15; return 8 * (i >> 2) + 4 * n + (i & 3); }

struct Unit { int pm, pn; };
struct Gemm { const bf16_t* A; const bf16_t* Bt; int M, N, K, lda; };

struct StaticOrder {
    int nM, nN, nwg, G, c;
    __host__ __device__ void init(int M, int N, int G_, int c_) { nM = M / BM; nN = N / BM; nwg = nM * nN; G = G_; c = c_; }
    __host__ __device__ bool next(int i, Unit& u) const {
        const long L = (long)i * G + c; if (L >= nwg) return false;
        int wgid = (int)L; { const int q = nwg / NXCD, r = nwg % NXCD, xcd = wgid % NXCD, off = wgid / NXCD; wgid = (xcd < r ? xcd * (q + 1) : r * (q + 1) + (xcd - r) * q) + off; }
        const int nig = WGM * nN, gid = wgid / nig, fm = gid * WGM, gsz = (nM - fm) < WGM ? (nM - fm) : WGM;
        u.pm = fm + ((wgid % nig) % gsz); u.pn = (wgid % nig) / gsz; return true;
    }
    __device__ __forceinline__ void a_ready(const Unit&) const {}
    __device__ __forceinline__ void done(const Unit&) const {}
};

__device__ __forceinline__ unsigned cvt_pk_bf16(float lo, float hi) { unsigned r; asm volatile("v_cvt_pk_bf16_f32 %0, %1, %2" : "=v"(r) : "v"(lo), "v"(hi)); return r; }

struct EpiScaleBf16 {
    static constexpr bool PERM = true, AFTER_DRAIN = false;
    bf16_t* O; int ldc; const float* ss;
    __device__ __forceinline__ void operator()(const f32x4 (&acc)[2][2][4][2], const Unit& u, int wr, int wc, int fr, int fq) const {
        const int row0 = u.pm * BM + wr * 64 + fr; const int col0 = u.pn * BM + wc * 32 + 8 * fq;
#pragma unroll
        for (int ai = 0; ai < 2; ++ai)
#pragma unroll
            for (int m = 0; m < 4; ++m) { const int row = row0 + ai * HALF + m * 16; const float sc = rsqrtf(ss[row] * (1.0f / 1024.0f) + EPS);
                bf16_t* rowp = O + (size_t)row * ldc + col0;
#pragma unroll
                for (int bj = 0; bj < 2; ++bj) { const f32x4 v0 = acc[ai][bj][m][0] * sc, v1 = acc[ai][bj][m][1] * sc;
                    u32x4 w; w.x = cvt_pk_bf16(v0[0], v0[1]); w.y = cvt_pk_bf16(v0[2], v0[3]); w.z = cvt_pk_bf16(v1[0], v1[1]); w.w = cvt_pk_bf16(v1[2], v1[3]);
                    *(u32x4*)(rowp + bj * HALF) = w; } }
    }
};
struct EpiResid {
    static constexpr bool PERM = false, AFTER_DRAIN = false;
    const float* xin; float* xout; bf16_t* xb; float* ss;
    __device__ __forceinline__ void operator()(const f32x4 (&acc)[2][2][4][2], const Unit& u, int wr, int wc, int fr, int fq) const {
        const int row0 = u.pm * BM + wr * 64 + fr; const int col0 = u.pn * BM + wc * 32 + 4 * fq;
#pragma unroll
        for (int ai = 0; ai < 2; ++ai)
#pragma unroll
            for (int m = 0; m < 4; ++m) { const int row = row0 + ai * HALF + m * 16; float s = 0.f;
#pragma unroll
                for (int bj = 0; bj < 2; ++bj)
#pragma unroll
                    for (int n = 0; n < 2; ++n) { const size_t off = (size_t)row * D_MODEL + col0 + bj * HALF + n * 16;
                        const f32x4 v = *(const f32x4*)(xin + off) + acc[ai][bj][m][n];
                        *(f32x4*)(xout + off) = v; s += (v[0] * v[0] + v[1] * v[1]) + (v[2] * v[2] + v[3] * v[3]);
                        if (xb) { u32x2 w; w.x = cvt_pk_bf16(v[0], v[1]); w.y = cvt_pk_bf16(v[2], v[3]); *(u32x2*)(xb + off) = w; } }
                s += __shfl_xor(s, 16); s += __shfl_xor(s, 32);
                if (fq == 0) atomicAdd(ss + row, s); }
    }
};

template <class Epi, class Sched, bool ALIGN_EPI = false, bool SP2 = false>
__device__ __forceinline__ void gemm_phase(LAS unsigned char* lds, const Gemm g, const Sched& S, const Epi& E) {
    const int tid = threadIdx.x, wid = __builtin_amdgcn_readfirstlane(tid >> 6), lane = tid & 63, wr = wid >> 2, wc = wid & 3, fr = lane & 15, fq = lane >> 4;
    const int K = g.K, nt = K / BK, lda = g.lda;
    unsigned voffA[2], voffB[2];
#pragma unroll
    for (int i = 0; i < 2; ++i) { int R, C; stage_rc(tid * 16 + i * 8192, R, C); const int Rb = Epi::PERM ? ((R & ~31) + perm32(R & 31)) : R;
        voffA[i] = (unsigned)(R * lda + C) * 2u; voffB[i] = (unsigned)(Rb * K + C) * 2u; }
    const size_t kstep = (size_t)(BK * 2);
    const size_t hstepA = (size_t)HALF * lda * 2, hstepB = (size_t)HALF * K * 2;
    const size_t tstepA = 2 * hstepA, tstepB = 2 * hstepB;
    const unsigned ldsw = (unsigned)wid * 1024u;
    const int aoff = lds_byte(wr * 64 + fr, fq * 8), boff = lds_byte(wc * 32 + fr, fq * 8);
#define PG8_SA(b, h) (((b) * 2 + (h)) * HTB)
#define PG8_SB(b, h) ((4 + (b) * 2 + (h)) * HTB)
#define PG8_STAGE(bufoff, gbase, voff) do { _Pragma("unroll") for (int _i = 0; _i < 2; ++_i) \
        __builtin_amdgcn_global_load_lds((const unsigned*)((const char*)(gbase) + (voff)[_i]), (LAS unsigned*)(lds + (bufoff) + ldsw + _i * 8192), 16, 0, 0); } while (0)
#define PG8_LDA(dst, b, h) do { _Pragma("unroll") for (int m = 0; m < 4; ++m) _Pragma("unroll") for (int k = 0; k < 2; ++k) dst[m][k] = *(const LAS bf16x8*)(lds + PG8_SA(b, h) + aoff + m * 2048 + k * 1024); } while (0)
#define PG8_LDB(dst, b, h) do { _Pragma("unroll") for (int n = 0; n < 2; ++n) _Pragma("unroll") for (int k = 0; k < 2; ++k) dst[n][k] = *(const LAS bf16x8*)(lds + PG8_SB(b, h) + boff + n * 2048 + k * 1024); } while (0)
#define PG8_MMA(ai, bj, At, Bt) do { __builtin_amdgcn_s_setprio(1); _Pragma("unroll") for (int m = 0; m < 4; ++m) _Pragma("unroll") for (int n = 0; n < 2; ++n) _Pragma("unroll") for (int k = 0; k < 2; ++k) \
        acc[ai][bj][m][n] = __builtin_amdgcn_mfma_f32_16x16x32_bf16(Bt[n][k], At[m][k], acc[ai][bj][m][n], 0, 0, 0); __builtin_amdgcn_s_setprio(0); } while (0)
#define PG8_WAIT_V(n) asm volatile("s_waitcnt vmcnt(" #n ")" ::: "memory")
#define PG8_WAIT_L(n) asm volatile("s_waitcnt lgkmcnt(" #n ")" ::: "memory")
#define PG8_BAR __builtin_amdgcn_s_barrier()
#define PG8_SCHED __builtin_amdgcn_sched_barrier(0)
    Unit cur, nxt; int ui = 0;
    if (!S.next(0, cur)) return;
    f32x4 acc[2][2][4][2];
#pragma unroll
    for (int a = 0; a < 2; ++a)
#pragma unroll
        for (int b = 0; b < 2; ++b)
#pragma unroll
            for (int m = 0; m < 4; ++m)
#pragma unroll
                for (int n = 0; n < 2; ++n) acc[a][b][m][n] = (f32x4){0.f, 0.f, 0.f, 0.f};
    bf16x8 At[4][2], B0[2][2], B1[2][2];
    const char* cA = (const char*)g.A + (size_t)cur.pm * tstepA; const char* cB = (const char*)g.Bt + (size_t)cur.pn * tstepB;
    S.a_ready(cur);
    if constexpr (SP2) {
        PG8_STAGE(PG8_SB(0, 0), cB, voffB); PG8_STAGE(PG8_SB(0, 1), cB + hstepB, voffB); PG8_STAGE(PG8_SA(0, 0), cA, voffA); PG8_STAGE(PG8_SA(0, 1), cA + hstepA, voffA);
        if (wr == 1) PG8_BAR;
        PG8_WAIT_V(2); PG8_BAR;
        PG8_STAGE(PG8_SB(1, 0), cB + kstep, voffB); PG8_STAGE(PG8_SA(1, 0), cA + kstep, voffA); PG8_STAGE(PG8_SB(1, 1), cB + hstepB + kstep, voffB);
        PG8_WAIT_V(6); PG8_BAR;
    } else {
        PG8_STAGE(PG8_SB(0, 0), cB, voffB); PG8_STAGE(PG8_SA(0, 0), cA, voffA); PG8_STAGE(PG8_SB(0, 1), cB + hstepB, voffB); PG8_STAGE(PG8_SA(0, 1), cA + hstepA, voffA);
        if (wr == 1) PG8_BAR;
        PG8_WAIT_V(4); PG8_BAR;
        PG8_STAGE(PG8_SB(1, 0), cB + kstep, voffB); PG8_STAGE(PG8_SA(1, 0), cA + kstep, voffA); PG8_STAGE(PG8_SB(1, 1), cB + hstepB + kstep, voffB);
        PG8_WAIT_V(6); PG8_BAR;
    }
    for (;;) {
        const bool has_next = S.next(ui + 1, nxt);
        const char* nA = has_next ? (const char*)g.A + (size_t)nxt.pm * tstepA : cA; const char* nB = has_next ? (const char*)g.Bt + (size_t)nxt.pn * tstepB : cB;
        for (int t = 0; t < nt; t += 2) {
            const bool last = (t == nt - 2);
            const char* a1 = cA + (size_t)(t + 1) * kstep;
            const char* a2 = last ? nA : cA + (size_t)(t + 2) * kstep; const char* b2 = last ? nB : cB + (size_t)(t + 2) * kstep;
            const char* a3 = a2 + kstep; const char* b3 = b2 + kstep;
            if (last && has_next) S.a_ready(nxt);
            if constexpr (SP2) {
            PG8_LDB(B0, 0, 0); PG8_LDB(B1, 0, 1); PG8_SCHED; PG8_LDA(At, 0, 0); PG8_STAGE(PG8_SA(1, 1), a1 + hstepA, voffA);
            PG8_WAIT_V(8); PG8_WAIT_L(0); PG8_BAR; PG8_MMA(0, 0, At, B0); PG8_MMA(0, 1, At, B1); PG8_BAR; PG8_SCHED;
            PG8_LDA(At, 0, 1); PG8_STAGE(PG8_SB(0, 0), b2, voffB); PG8_STAGE(PG8_SB(0, 1), b2 + hstepB, voffB); PG8_STAGE(PG8_SA(0, 0), a2, voffA);
            PG8_WAIT_V(8); PG8_WAIT_L(0); PG8_BAR; PG8_MMA(1, 0, At, B0); PG8_MMA(1, 1, At, B1); PG8_BAR; PG8_SCHED;
            PG8_LDB(B0, 1, 0); PG8_LDB(B1, 1, 1); PG8_SCHED; PG8_LDA(At, 1, 0); PG8_STAGE(PG8_SA(0, 1), a2 + hstepA, voffA);
            PG8_WAIT_V(8); PG8_WAIT_L(0); PG8_BAR; PG8_MMA(0, 0, At, B0); PG8_MMA(0, 1, At, B1); PG8_BAR; PG8_SCHED;
            PG8_LDA(At, 1, 1); PG8_STAGE(PG8_SB(1, 0), b3, voffB); PG8_STAGE(PG8_SB(1, 1), b3 + hstepB, voffB); PG8_STAGE(PG8_SA(1, 0), a3, voffA);
            PG8_WAIT_V(8); PG8_WAIT_L(0); PG8_BAR; PG8_MMA(1, 0, At, B0); PG8_MMA(1, 1, At, B1); PG8_BAR; PG8_SCHED;
            } else {
            PG8_LDB(B0, 0, 0); PG8_SCHED; PG8_LDA(At, 0, 0); PG8_STAGE(PG8_SA(1, 1), a1 + hstepA, voffA);
            PG8_WAIT_L(8); PG8_BAR; PG8_WAIT_L(0); PG8_MMA(0, 0, At, B0); PG8_BAR; PG8_SCHED;
            PG8_LDB(B1, 0, 1); PG8_STAGE(PG8_SB(0, 0), b2, voffB);
            PG8_BAR; PG8_WAIT_L(0); PG8_MMA(0, 1, At, B1); PG8_BAR;
            PG8_LDA(At, 0, 1); PG8_STAGE(PG8_SA(0, 0), a2, voffA);
            PG8_BAR; PG8_WAIT_L(0); PG8_MMA(1, 0, At, B0); PG8_BAR; PG8_SCHED;
            PG8_STAGE(PG8_SB(0, 1), b2 + hstepB, voffB);
            PG8_WAIT_V(6); PG8_BAR; PG8_MMA(1, 1, At, B1); PG8_BAR;
            PG8_LDB(B0, 1, 0); PG8_SCHED; PG8_LDA(At, 1, 0); PG8_STAGE(PG8_SA(0, 1), a2 + hstepA, voffA);
            PG8_WAIT_L(8); PG8_BAR; PG8_WAIT_L(0); PG8_MMA(0, 0, At, B0); PG8_BAR; PG8_SCHED;
            PG8_LDB(B1, 1, 1); PG8_STAGE(PG8_SB(1, 0), b3, voffB);
            PG8_BAR; PG8_WAIT_L(0); PG8_MMA(0, 1, At, B1); PG8_BAR;
            PG8_LDA(At, 1, 1); PG8_STAGE(PG8_SA(1, 0), a3, voffA);
            PG8_BAR; PG8_WAIT_L(0); PG8_MMA(1, 0, At, B0); PG8_BAR; PG8_SCHED;
            PG8_STAGE(PG8_SB(1, 1), b3 + hstepB, voffB);
            PG8_WAIT_V(6); PG8_BAR; PG8_MMA(1, 1, At, B1); PG8_BAR;
            }
        }
        if constexpr (ALIGN_EPI) { if (wr == 0) PG8_BAR; }
        if constexpr (!Epi::AFTER_DRAIN) { E(acc, cur, wr, wc, fr, fq); S.done(cur); }
        if (!has_next) break;
#pragma unroll
        for (int a = 0; a < 2; ++a)
#pragma unroll
            for (int b = 0; b < 2; ++b)
#pragma unroll
                for (int m = 0; m < 4; ++m)
#pragma unroll
                    for (int n = 0; n < 2; ++n) acc[a][b][m][n] = (f32x4){0.f, 0.f, 0.f, 0.f};
        cur = nxt; cA = nA; cB = nB; ++ui;
        if constexpr (ALIGN_EPI) { if (wr == 1) PG8_BAR; }
    }
    PG8_WAIT_V(0);
    if constexpr (!ALIGN_EPI) { if (wr == 0) PG8_BAR; }
    PG8_BAR;
#undef PG8_SA
#undef PG8_SB
#undef PG8_STAGE
#undef PG8_LDA
#undef PG8_LDB
#undef PG8_MMA
#undef PG8_WAIT_V
#undef PG8_WAIT_L
#undef PG8_BAR
#undef PG8_SCHED
}
}

namespace xattn {
using bf16 = __hip_bfloat16;
constexpr int D = 128, NW = 8, QBLK = 32, KVBLK = 64;
constexpr float SCALE = 0.088388347648318440f;
constexpr float THR = 8.f;
constexpr int SDEPTH = 1;
constexpr int LDQ = P_IN, LDK = 2048;
constexpr size_t SHM_V = KVBLK * D * 2, SHM_K = KVBLK * D * 2, SHM_ATTN = 2 * SHM_V + 2 * SHM_K + NW * 64 * 4;
using s16x4 = __attribute__((ext_vector_type(4))) short;
using f32x16 = __attribute__((ext_vector_type(16))) float;
#define KSWZ(row, colB) ((row) * 256 + ((colB) ^ (((row) & 7) << 4)))
#define SBAR() __builtin_amdgcn_sched_barrier(0)
__device__ __forceinline__ int crow(int r, int hi) { return (r & 3) + 8 * (r >> 2) + 4 * hi; }
__device__ __forceinline__ unsigned cvtpk(float lo, float hi) { unsigned r; asm volatile("v_cvt_pk_bf16_f32 %0, %1, %2" : "=v"(r) : "v"(lo), "v"(hi)); return r; }
__device__ __forceinline__ bf16x8 ld8(const bf16* p) { return *reinterpret_cast<const bf16x8*>(p); }

__device__ __forceinline__ void partialSM(f32x16& p0, f32x16& p1, float& m_reg, float& mn, float& alpha) {
  constexpr float C = SCALE * 1.4426950408889634f;
  float pmax = p0[0]; for (int r = 1; r < 16; ++r) pmax = fmaxf(pmax, p0[r]); for (int r = 0; r < 16; ++r) pmax = fmaxf(pmax, p1[r]);
  { auto rr = __builtin_amdgcn_permlane32_swap(__float_as_uint(pmax), __float_as_uint(pmax), false, false);
    pmax = fmaxf(__uint_as_float(rr[0]), __uint_as_float(rr[1])); }
  if (__builtin_expect(__all(pmax - m_reg <= THR / SCALE), 1)) { mn = m_reg; alpha = 1.f; }
  else { mn = fmaxf(m_reg, pmax); alpha = __builtin_amdgcn_exp2f((m_reg - mn) * C); m_reg = mn; }
  float mnC = -mn * C;
  for (int r = 0; r < 16; ++r) p0[r] = fmaf(p0[r], C, mnC); for (int r = 0; r < 16; ++r) p1[r] = fmaf(p1[r], C, mnC);
  for (int r = 0; r < 16; ++r) p0[r] = __builtin_amdgcn_exp2f(p0[r]);
}
__device__ __forceinline__ void finishSM(f32x16& p0, f32x16& p1, float alpha, float& l_reg, bf16x8& pa0, bf16x8& pa1, bf16x8& pa2, bf16x8& pa3) {
  for (int r = 0; r < 16; ++r) p1[r] = __builtin_amdgcn_exp2f(p1[r]);
  float ps = 0; for (int r = 0; r < 16; ++r) ps += p0[r]; for (int r = 0; r < 16; ++r) ps += p1[r];
  { auto rr = __builtin_amdgcn_permlane32_swap(__float_as_uint(ps), __float_as_uint(ps), false, false);
    ps = __uint_as_float(rr[0]) + __uint_as_float(rr[1]); }
  l_reg = l_reg * alpha + ps;
#define PK4(P, BASE, OUT) do { unsigned a0 = cvtpk(P[BASE + 0], P[BASE + 1]), a1 = cvtpk(P[BASE + 2], P[BASE + 3]);   \
    unsigned b0 = cvtpk(P[BASE + 4], P[BASE + 5]), b1 = cvtpk(P[BASE + 6], P[BASE + 7]);                              \
    auto r0 = __builtin_amdgcn_permlane32_swap(a0, b0, false, false); auto r1 = __builtin_amdgcn_permlane32_swap(a1, b1, false, false); \
    u32x4 w = {r0[0], r1[0], r0[1], r1[1]}; OUT = *reinterpret_cast<bf16x8*>(&w); } while (0)
  PK4(p0, 0, pa0); PK4(p0, 8, pa1); PK4(p1, 0, pa2); PK4(p1, 8, pa3);
#undef PK4
}
__device__ __forceinline__ void qkt(f32x16& p0, f32x16& p1, const bf16* Ks, const bf16x8* qr, int r32, int hi) {
  p0 = f32x16{}; p1 = f32x16{};
  for (int d0 = 0; d0 < 8; ++d0) { int cb = (d0 * 16 + hi * 8) * 2;
    bf16x8 b0 = *reinterpret_cast<const bf16x8*>((const char*)Ks + KSWZ(r32, cb));
    bf16x8 b1 = *reinterpret_cast<const bf16x8*>((const char*)Ks + KSWZ(32 + r32, cb));
    p0 = __builtin_amdgcn_mfma_f32_32x32x16_bf16(b0, qr[d0], p0, 0, 0, 0);
    p1 = __builtin_amdgcn_mfma_f32_32x32x16_bf16(b1, qr[d0], p1, 0, 0, 0); }
}
__device__ __forceinline__ int v_st(int k, int c) { const int kk = (k & ~0xC) | ((k & 4) << 1) | ((k & 8) >> 1); return ((kk >> 3) * 4 + (c >> 5)) * 512 + ((kk & 7) * 32 + (c & 31)) * 2; }
__device__ __forceinline__ int v_rd_base(int lane) { return ((lane & 3) << 3) | (((lane >> 2) & 3) << 6) | (((lane >> 4) & 1) << 5) | (((lane >> 5) & 1) << 8); }
constexpr int v_rd_off(int d0, int ks, int half) { return d0 * 512 + ks * 4096 + half * 2048; }
template <int OFF> __device__ __forceinline__ s16x4 tr_read(int vb) {
  s16x4 r; asm volatile("ds_read_b64_tr_b16 %0, %1 offset:%2" : "=&v"(r) : "v"(vb), "i"(OFF) : "memory"); return r;
}
template <int D0> __device__ __forceinline__ void pv_one(f32x16& od, int vb, bf16x8 pa0, bf16x8 pa1, bf16x8 pa2, bf16x8 pa3) {
  const s16x4 l0 = tr_read<v_rd_off(D0, 0, 0)>(vb), h0 = tr_read<v_rd_off(D0, 0, 1)>(vb), l1 = tr_read<v_rd_off(D0, 1, 0)>(vb), h1 = tr_read<v_rd_off(D0, 1, 1)>(vb);
  const s16x4 l2 = tr_read<v_rd_off(D0, 2, 0)>(vb), h2 = tr_read<v_rd_off(D0, 2, 1)>(vb), l3 = tr_read<v_rd_off(D0, 3, 0)>(vb), h3 = tr_read<v_rd_off(D0, 3, 1)>(vb);
  asm volatile("s_waitcnt lgkmcnt(0)" ::: "memory"); SBAR();
#define PK(L, H) (bf16x8){L[0], L[1], L[2], L[3], H[0], H[1], H[2], H[3]}
  od = __builtin_amdgcn_mfma_f32_32x32x16_bf16(pa0, PK(l0, h0), od, 0, 0, 0);
  od = __builtin_amdgcn_mfma_f32_32x32x16_bf16(pa1, PK(l1, h1), od, 0, 0, 0);
  od = __builtin_amdgcn_mfma_f32_32x32x16_bf16(pa2, PK(l2, h2), od, 0, 0, 0);
  od = __builtin_amdgcn_mfma_f32_32x32x16_bf16(pa3, PK(l3, h3), od, 0, 0, 0);
#undef PK
}
__device__ __forceinline__ void pv_d0(f32x16* o, int vb, bf16x8 pa0, bf16x8 pa1, bf16x8 pa2, bf16x8 pa3) {
  pv_one<0>(o[0], vb, pa0, pa1, pa2, pa3); pv_one<1>(o[1], vb, pa0, pa1, pa2, pa3); pv_one<2>(o[2], vb, pa0, pa1, pa2, pa3); pv_one<3>(o[3], vb, pa0, pa1, pa2, pa3);
}
__device__ __forceinline__ void attn_body(const bf16* Qb, const bf16* Kh, const bf16* Vh, bf16_t* Gb, const float* nw, int seq, char* lds) {
  const int tid = threadIdx.x, wid = tid >> 6, lane = tid & 63, r32 = lane & 31, hi = lane >> 5;
  bf16* V_lds = (bf16*)lds; bf16* K_lds = (bf16*)(lds + 2 * SHM_V);
  float* ws = (float*)(lds + 2 * SHM_V + 2 * SHM_K) + wid * 64; float* li_l = ws; float* al_l = ws + 32;
  float m_reg = -1e30f, l_reg = 0; f32x16 o[4] = {}; bf16x8 qr[8];
  const bf16* Qw = Qb + (long)(wid * QBLK + r32) * LDQ + hi * 8;
#pragma unroll
  for (int d0 = 0; d0 < 8; ++d0) qr[d0] = ld8(Qw + d0 * 16);
  const int sr = tid >> 4, sc = (tid & 15) * 8, vst0 = v_st(sr, sc), vst1 = v_st(32 + sr, sc);
  const int vb0 = (int)(uintptr_t)V_lds + v_rd_base(lane);
  struct { bf16x8 vs0, vs1, ks0, ks1; } sr_[SDEPTH];
#define SLOAD(i, k0) do { sr_[i].vs0 = ld8(&Vh[(long)((k0) + sr) * LDK + sc]); sr_[i].vs1 = ld8(&Vh[(long)((k0) + 32 + sr) * LDK + sc]); \
    sr_[i].ks0 = ld8(&Kh[(long)((k0) + sr) * LDK + sc]); sr_[i].ks1 = ld8(&Kh[(long)((k0) + 32 + sr) * LDK + sc]); } while (0)
#define SWRITE(b, i) do { *(bf16x8*)((char*)V_lds + (b) * SHM_V + vst0) = sr_[i].vs0;          \
    *(bf16x8*)((char*)V_lds + (b) * SHM_V + vst1) = sr_[i].vs1; int kc = sc * 2;               \
    *(bf16x8*)((char*)K_lds + (b) * SHM_K + KSWZ(sr, kc)) = sr_[i].ks0;                       \
    *(bf16x8*)((char*)K_lds + (b) * SHM_K + KSWZ(32 + sr, kc)) = sr_[i].ks1; } while (0)
#define SWAIT() do { if constexpr (SDEPTH == 2) asm volatile("s_waitcnt vmcnt(4)" ::: "memory"); else asm volatile("s_waitcnt vmcnt(0)" ::: "memory"); } while (0)
#define RESC(a) do { if (__any((a) < 1.f)) { if (hi == 0) al_l[r32] = (a); asm volatile("s_waitcnt lgkmcnt(0)" ::: "memory"); \
    for (int d = 0; d < 4; ++d) for (int r = 0; r < 16; ++r) o[d][r] *= al_l[crow(r, hi)]; } } while (0)
  f32x16 pA0, pA1; float mnA, alA; bf16x8 pa0, pa1, pa2, pa3; const int NT = seq / KVBLK;
  SLOAD(0, 0); asm volatile("s_waitcnt vmcnt(0)" ::: "memory"); SWRITE(0, 0); __syncthreads();
  for (int j = 0; j < NT; ++j) {
    const int bb = j & 1;
    if (j + 1 < NT) SLOAD(0, (j + 1) * KVBLK);
    SBAR(); qkt(pA0, pA1, (bf16*)((char*)K_lds + bb * SHM_K), qr, r32, hi);
    partialSM(pA0, pA1, m_reg, mnA, alA); RESC(alA);
    finishSM(pA0, pA1, alA, l_reg, pa0, pa1, pa2, pa3); SBAR();
    pv_d0(o, vb0 + bb * (int)SHM_V, pa0, pa1, pa2, pa3);
    if (j + 1 < NT) { asm volatile("s_waitcnt vmcnt(0)" ::: "memory"); SWRITE(bb ^ 1, 0); }
    __syncthreads();
  }
  if (hi == 0) li_l[r32] = l_reg; asm volatile("s_waitcnt lgkmcnt(0)" ::: "memory");
  float rli[16];
#pragma unroll
  for (int r = 0; r < 16; ++r) rli[r] = __builtin_amdgcn_rcpf(li_l[crow(r, hi)]);
  float ssq[16];
#pragma unroll
  for (int r = 0; r < 16; ++r) { float s = 0.f;
#pragma unroll
    for (int d0 = 0; d0 < 4; ++d0) { const float vv = o[d0][r] * rli[r]; o[d0][r] = vv; s += vv * vv; }
    ssq[r] = s; }
#pragma unroll
  for (int off = 1; off < 32; off <<= 1)
#pragma unroll
    for (int r = 0; r < 16; ++r) ssq[r] += __shfl_xor(ssq[r], off);
  bf16_t* Gw = Gb + (long)(wid * QBLK) * LDQ;
  float nwv[4];
#pragma unroll
  for (int d0 = 0; d0 < 4; ++d0) nwv[d0] = nw[d0 * 32 + r32];
#pragma unroll
  for (int r = 0; r < 16; ++r) { const int orow = crow(r, hi); const float rs = rsqrtf(ssq[r] * (1.0f / 128.0f) + EPS);
#pragma unroll
    for (int d0 = 0; d0 < 4; ++d0) { bf16_t* gp = Gw + (long)orow * LDQ + d0 * 32 + r32; const float gt = bf2f(*gp);
      *gp = (bf16_t)f2bf(o[d0][r] * rs * nwv[d0] * silu_f(gt)); } }
#undef SLOAD
#undef SWRITE
#undef SWAIT
#undef RESC
}
#undef KSWZ
#undef SBAR
}

struct Params {
    const float* in[20]; float* out; unsigned char* ws; int ph_lo, ph_hi;
};
struct Ctx {
    LAS unsigned char* lds; int tid, lane, wave, G;
    const float* const* inp;
    float* out; unsigned char* ws;
};
#define F_IN(k) (F.inp[k])
#define F_x F_IN(0)
#define F_mem F_IN(1)
#define F_norm_w F_IN(2)
#define F_w_in F_IN(3)
#define F_lb_logits F_IN(4)
#define F_hgrn_norm_w F_IN(5)
#define F_conv_w F_IN(6)
#define F_conv_b F_IN(7)
#define F_wq F_IN(8)
#define F_wk F_IN(9)
#define F_wv F_IN(10)
#define F_w_gate F_IN(11)
#define F_b_gate F_IN(12)
#define F_ml_norm_w F_IN(13)
#define F_ml_skip F_IN(14)
#define F_mem_norm_w F_IN(15)
#define F_w_kv F_IN(16)
#define F_xa_norm_w F_IN(17)
#define F_w_out F_IN(18)
#define F_final_w F_IN(19)
#define F_ctl ((unsigned*)(F.ws + WS_CTL))
#define F_WinT ((bf16_t*)(F.ws + WS_WIN))
#define F_WkvT ((bf16_t*)(F.ws + WS_WKV))
#define F_WoutT ((bf16_t*)(F.ws + WS_WOUT))
#define F_memb ((bf16_t*)(F.ws + WS_MEMB))
#define F_mkv ((bf16_t*)(F.ws + WS_MKV))
#define F_xb ((bf16_t*)(F.ws + WS_XB))
#define F_proj ((bf16_t*)(F.ws + WS_PROJ))
#define F_ss0 ((float*)(F.ws + WS_SS0))
#define F_ss1 ((float*)(F.ws + WS_SS1))
#define F_ss2 ((float*)(F.ws + WS_SS2))
#define F_ssm ((float*)(F.ws + WS_SSM))
#define F_lb ((float*)(F.ws + WS_LB))
#define F_gates ((float*)(F.ws + WS_GATES))

__device__ __forceinline__ void transpose_item(const float* W, int ldw, int K, int k0, int nsrc, bf16_t* WT, int ndst, const float* kscale, LAS float* scr, int lane) {
#pragma unroll 8
    for (int i = 0; i < 32; ++i) { const int kk = 2 * i + (lane >> 5); float v = W[(size_t)(k0 + kk) * ldw + nsrc + (lane & 31)]; if (kscale) v *= kscale[k0 + kk]; scr[kk * 33 + (lane & 31)] = v; }
    asm volatile("s_waitcnt lgkmcnt(0)" ::: "memory");
    const int c = lane & 7;
#pragma unroll
    for (int j = 0; j < 4; ++j) { const int n = (lane >> 3) + 8 * j; const LAS float* s = scr + (8 * c) * 33 + n;
        u32x4 o; o.x = pk2(s[0 * 33], s[1 * 33]); o.y = pk2(s[2 * 33], s[3 * 33]); o.z = pk2(s[4 * 33], s[5 * 33]); o.w = pk2(s[6 * 33], s[7 * 33]);
        *(u32x4*)(WT + (size_t)(ndst + n) * K + k0 + 8 * c) = o; }
    asm volatile("s_waitcnt lgkmcnt(0)" ::: "memory");
}

__device__ __forceinline__ void phase_prep(Ctx& F) {
    LAS float* scr = (LAS float*)(F.lds + F.wave * 16384);
    const int gw = blockIdx.x * 8 + F.wave, NGW = F.G * 8;
    constexpr int I_IN = DEPTH * 16 * 176, I_KV = DEPTH * 16 * 32, I_OUT = DEPTH * 32 * 32;
    for (int it = gw; it < I_IN + I_KV + I_OUT; it += NGW) {
        int r = it;
        if (r < I_IN) { const int l = r / (16 * 176), rr = r % (16 * 176), kb = rr / 176, nb = rr % 176;
            transpose_item(F_w_in + (size_t)l * D_MODEL * P_IN, P_IN, D_MODEL, kb * 64, src_col(nb * 32), F_WinT + (size_t)l * P_IN * D_MODEL, nb * 32, F_norm_w + l * D_MODEL, scr, F.lane); continue; }
        r -= I_IN;
        if (r < I_KV) { const int l = r / (16 * 32), rr = r % (16 * 32), kb = rr / 32, nb = rr % 32;
            transpose_item(F_w_kv + (size_t)l * D_MODEL * 1024, 1024, D_MODEL, kb * 64, nb * 32, F_WkvT + (size_t)l * 1024 * D_MODEL, nb * 32, F_mem_norm_w + l * D_MODEL, scr, F.lane); continue; }
        r -= I_KV;
        { const int l = r / (32 * 32), rr = r % (32 * 32), kb = rr / 32, nb = rr % 32;
            transpose_item(F_w_out + (size_t)l * D_MIX * D_MODEL, D_MODEL, D_MIX, kb * 64, nb * 32, F_WoutT + (size_t)l * D_MODEL * D_MIX, nb * 32, nullptr, scr, F.lane); }
    }
    for (int row = gw; row < M_TOK + M_MEM; row += NGW) {
        const bool isx = row < M_TOK; const int r = isx ? row : row - M_TOK;
        const f32x4* src = (const f32x4*)((isx ? F_x : F_mem) + (size_t)r * D_MODEL) + F.lane;
        u32x2* dst = (u32x2*)((isx ? F_xb : F_memb) + (size_t)r * D_MODEL) + F.lane;
        f32x4 v[4]; float s = 0.f;
#pragma unroll
        for (int j = 0; j < 4; ++j) { v[j] = src[64 * j]; s += (v[j][0] * v[j][0] + v[j][1] * v[j][1]) + (v[j][2] * v[j][2] + v[j][3] * v[j][3]); }
        s = wave_sum(s);
        if (F.lane == 0) (isx ? F_ss0 : F_ssm)[r] = s;
#pragma unroll
        for (int j = 0; j < 4; ++j) { u32x2 w; w.x = pk2(v[j][0], v[j][1]); w.y = pk2(v[j][2], v[j][3]); dst[64 * j] = w; }
    }
    const int gt = blockIdx.x * 512 + F.tid, NGT = F.G * 512;
    for (int i = gt; i < 2 * M_TOK; i += NGT) F_ss1[i] = 0.f;
    for (int i = gt; i < 768; i += NGT) { const float l0 = F_lb_logits[i], l1 = F_lb_logits[768 + i]; const float mx = fmaxf(l0, l1);
        const float e0 = __expf(l0 - mx), e1 = __expf(l1 - mx); const float s0 = e0 / (e0 + e1), s1 = e1 / (e0 + e1);
        F_lb[i] = fmaxf(s0 - s0, 0.f); F_lb[768 + i] = fmaxf((s0 + s1) - s0, 0.f); }
}

__device__ __forceinline__ void phase_gates(Ctx& F, int l) {
    const int gw = blockIdx.x * 8 + F.wave, NGW = F.G * 8, lane = F.lane;
    const float* cw = F_conv_w + l * 4 * 768; const float* cb = F_conv_b + l * 768;
    const float* wq = F_wq + l * 192 * 16; const float* wk = F_wk + l * 192 * 16; const float* wv = F_wv + l * 192 * 16;
    const float* wg = F_w_gate + (size_t)l * 2304 * 8; const float* bg = F_b_gate + l * 8;
    for (int tok = gw; tok < M_TOK; tok += NGW) {
        const int t = tok & (SEQ - 1);
        float G[8];
#pragma unroll
        for (int n = 0; n < 8; ++n) G[n] = 0.f;
#pragma unroll 1
        for (int gi = 0; gi < 3; ++gi) {
            const int g = lane + 64 * gi, c = 4 * g;
            float xr[4][4];
#pragma unroll
            for (int j = 0; j < 4; ++j) { const int tt = t - 3 + j;
                if (tt >= 0) { const u32x2 w = *(const u32x2*)(F_proj + (size_t)(tok - 3 + j) * P_IN + O_MX + c);
                    xr[j][0] = __uint_as_float(w.x << 16); xr[j][1] = __uint_as_float(w.x & 0xffff0000u); xr[j][2] = __uint_as_float(w.y << 16); xr[j][3] = __uint_as_float(w.y & 0xffff0000u); }
                else { xr[j][0] = xr[j][1] = xr[j][2] = xr[j][3] = 0.f; } }
            float xc[4];
#pragma unroll
            for (int i = 0; i < 4; ++i) { float a = cb[c + i];
#pragma unroll
                for (int j = 0; j < 4; ++j) a += cw[j * 768 + c + i] * xr[j][i];
                xc[i] = silu_f(a); }
#pragma unroll 1
            for (int o = 0; o < 4; ++o) { float q = 0.f, k = 0.f, v = 0.f;
#pragma unroll
                for (int i = 0; i < 4; ++i) { q += xc[i] * wq[g * 16 + i * 4 + o]; k += xc[i] * wk[g * 16 + i * 4 + o]; v += xr[3][i] * wv[g * 16 + i * 4 + o]; }
                const f32x4 gq0 = *(const f32x4*)(wg + (size_t)(c + o) * 8), gq1 = *(const f32x4*)(wg + (size_t)(c + o) * 8 + 4);
                const f32x4 gk0 = *(const f32x4*)(wg + (size_t)(768 + c + o) * 8), gk1 = *(const f32x4*)(wg + (size_t)(768 + c + o) * 8 + 4);
                const f32x4 gv0 = *(const f32x4*)(wg + (size_t)(1536 + c + o) * 8), gv1 = *(const f32x4*)(wg + (size_t)(1536 + c + o) * 8 + 4);
#pragma unroll
                for (int n = 0; n < 4; ++n) { G[n] += q * gq0[n] + k * gk0[n] + v * gv0[n]; G[4 + n] += q * gq1[n] + k * gk1[n] + v * gv1[n]; } }
        }
#pragma unroll
        for (int n = 0; n < 8; ++n) G[n] = wave_sum(G[n]);
        if (lane == 0) {
            f32x4 o0, o1;
#pragma unroll
            for (int n = 0; n < 4; ++n) { o0[n] = G[n] + bg[n]; const float f = G[4 + n] + bg[4 + n]; o1[n] = fminf(f, 0.f) - log1pf(__expf(-fabsf(f))); }
            *(f32x4*)(F_gates + (size_t)tok * 8) = o0; *(f32x4*)(F_gates + (size_t)tok * 8 + 4) = o1;
        }
    }
}

__device__ __forceinline__ void hgrn_item(Ctx& F, int l, int b, int h) {
    constexpr int CH = 16;
    LAS float* QS = (LAS float*)(F.lds); LAS float* FF = QS + CH * 128; LAS float* KK = FF + CH * 128; LAS float* VV = KK + CH * 128; LAS float* PART = VV + CH * 128;
    const int tid = F.tid, v = tid & 127, qd = tid >> 7;
    float S[32];
#pragma unroll
    for (int i = 0; i < 32; ++i) S[i] = 0.f;
    const float* lb = F_lb + l * 768 + h * 128; const float* nw = F_hgrn_norm_w + l * 128;
    const size_t row0 = (size_t)b * SEQ;
    for (int c = 0; c < SEQ / CH; ++c) {
        for (int e = tid; e < CH * 128; e += 512) { const int t = e >> 7, ch = e & 127; const bf16_t* rp = F_proj + (row0 + c * CH + t) * P_IN + h * 128 + ch;
            const float q = bf2f(rp[O_HQ]), f = bf2f(rp[O_HF]), vi = bf2f(rp[O_HI]); const float lbv = lb[ch];
            const float e1 = __expf(-fabsf(f)), inv = 1.f / (1.f + e1); const float sg = f >= 0.f ? inv : e1 * inv, sgn = f >= 0.f ? e1 * inv : inv;
            QS[e] = silu_f(q) * 0.08838834764831845f; FF[e] = lbv + (1.f - lbv) * sg; KK[e] = (1.f - lbv) * sgn; VV[e] = vi; }
        __syncthreads();
        for (int t = 0; t < CH; ++t) { const float vt = VV[t * 128 + v]; float a = 0.f;
#pragma unroll
            for (int i = 0; i < 32; ++i) { const int d = qd * 32 + i; S[i] = FF[t * 128 + d] * S[i] + KK[t * 128 + d] * vt; a += QS[t * 128 + d] * S[i]; }
            PART[(t * 4 + qd) * 128 + v] = a; }
        __syncthreads();
        { const int t = tid >> 5, v0 = (tid & 31) * 4; float o[4]; float ss = 0.f;
#pragma unroll
            for (int j = 0; j < 4; ++j) { o[j] = (PART[(t * 4 + 0) * 128 + v0 + j] + PART[(t * 4 + 1) * 128 + v0 + j]) + (PART[(t * 4 + 2) * 128 + v0 + j] + PART[(t * 4 + 3) * 128 + v0 + j]); ss += o[j] * o[j]; }
#pragma unroll
            for (int off = 1; off < 32; off <<= 1) ss += __shfl_xor(ss, off);
            const float rs = rsqrtf(ss * (1.0f / 128.0f) + EPS);
            bf16_t* gp = F_proj + (row0 + c * CH + t) * P_IN + O_HG + h * 128 + v0; const u32x2 gw = *(const u32x2*)gp;
            const float g0 = __uint_as_float(gw.x << 16), g1 = __uint_as_float(gw.x & 0xffff0000u), g2 = __uint_as_float(gw.y << 16), g3 = __uint_as_float(gw.y & 0xffff0000u);
            u32x2 w; w.x = pk2(o[0] * rs * nw[v0] * silu_f(g0), o[1] * rs * nw[v0 + 1] * silu_f(g1)); w.y = pk2(o[2] * rs * nw[v0 + 2] * silu_f(g2), o[3] * rs * nw[v0 + 3] * silu_f(g3));
            *(u32x2*)gp = w; }
    }
}

__device__ __forceinline__ void mlstm_item(Ctx& F, int l, int b, int h) {
    constexpr int CH = 16, VS = 196;
    LAS float* Q = (LAS float*)(F.lds); LAS float* K = Q + CH * 192; LAS float* V = K + CH * 192; LAS float* XC = V + CH * VS; LAS float* PART = XC + CH * 192;
    LAS float* FW = PART + CH * 2 * VS; LAS float* IW = FW + CH; LAS float* MM = IW + CH; LAS float* MST = MM + CH;
    const int tid = F.tid, v = tid & 255, half = tid >> 8, lane = F.lane, wave = F.wave;
    float C[96];
#pragma unroll
    for (int i = 0; i < 96; ++i) C[i] = 0.f;
    if (tid == 0) MST[0] = -1e30f;
    const float* cw = F_conv_w + l * 4 * 768 + h * 192; const float* cb = F_conv_b + l * 768 + h * 192;
    const float* wq = F_wq + (l * 192 + h * 48) * 16; const float* wk = F_wk + (l * 192 + h * 48) * 16; const float* wv = F_wv + (l * 192 + h * 48) * 16;
    const float* nw = F_ml_norm_w + l * 768 + h * 192; const float* sk = F_ml_skip + l * 768 + h * 192;
    const size_t row0 = (size_t)b * SEQ;
    for (int c = 0; c < SEQ / CH; ++c) {
        for (int idx = tid; idx < CH * 48; idx += 512) { const int g = idx % 48, t = idx / 48, tg = c * CH + t, cc = 4 * g;
            float xr[4][4];
#pragma unroll
            for (int j = 0; j < 4; ++j) { const int tt = tg - 3 + j;
                if (tt >= 0) { const u32x2 w = *(const u32x2*)(F_proj + (row0 + tt) * P_IN + O_MX + h * 192 + cc);
                    xr[j][0] = __uint_as_float(w.x << 16); xr[j][1] = __uint_as_float(w.x & 0xffff0000u); xr[j][2] = __uint_as_float(w.y << 16); xr[j][3] = __uint_as_float(w.y & 0xffff0000u); }
                else { xr[j][0] = xr[j][1] = xr[j][2] = xr[j][3] = 0.f; } }
            float xc[4];
#pragma unroll
            for (int i = 0; i < 4; ++i) { float a = cb[cc + i];
#pragma unroll
                for (int j = 0; j < 4; ++j) a += cw[j * 768 + cc + i] * xr[j][i];
                xc[i] = silu_f(a); XC[t * 192 + cc + i] = xc[i]; }
#pragma unroll
            for (int o = 0; o < 4; ++o) { float q = 0.f, k = 0.f, vv = 0.f;
#pragma unroll
                for (int i = 0; i < 4; ++i) { q += xc[i] * wq[g * 16 + i * 4 + o]; k += xc[i] * wk[g * 16 + i * 4 + o]; vv += xr[3][i] * wv[g * 16 + i * 4 + o]; }
                Q[t * 192 + cc + o] = q; K[t * 192 + cc + o] = k * 0.07216878364870323f; V[t * VS + cc + o] = vv; } }
        if (tid < CH) V[tid * VS + 192] = 1.f;
        if (tid == 0) { float m = MST[0];
            for (int t = 0; t < CH; ++t) { const float* gp = F_gates + (row0 + c * CH + t) * 8; const float ip = gp[h], lf = gp[4 + h];
                const float mn = fmaxf(lf + m, ip); FW[t] = __expf(lf + m - mn); IW[t] = __expf(ip - mn); MM[t] = mn; m = mn; }
            MST[0] = m; }
        __syncthreads();
        if (v < 193) {
            for (int t = 0; t < CH; ++t) { const float fw = FW[t], ivt = IW[t] * V[t * VS + v]; float a = 0.f;
#pragma unroll
                for (int i = 0; i < 96; ++i) { const int d = half * 96 + i; C[i] = fw * C[i] + K[t * 192 + d] * ivt; a += Q[t * 192 + d] * C[i]; }
                PART[(t * 2 + half) * VS + v] = a; }
        }
        __syncthreads();
        for (int tt = 0; tt < 2; ++tt) { const int t = wave * 2 + tt;
            const float den = PART[(t * 2) * VS + 192] + PART[(t * 2 + 1) * VS + 192]; const float dn = fmaxf(fabsf(den), __expf(-MM[t])); const float idn = 1.f / dn;
            float hv[3]; float s = 0.f;
#pragma unroll
            for (int j = 0; j < 3; ++j) { const int vi = lane + 64 * j; hv[j] = (PART[(t * 2) * VS + vi] + PART[(t * 2 + 1) * VS + vi]) * idn; s += hv[j]; }
            const float mean = wave_sum(s) * (1.0f / 192.0f); float q2 = 0.f;
#pragma unroll
            for (int j = 0; j < 3; ++j) { hv[j] -= mean; q2 += hv[j] * hv[j]; }
            const float rs = rsqrtf(wave_sum(q2) * (1.0f / 192.0f) + EPS);
            bf16_t* zp = F_proj + (row0 + c * CH + t) * P_IN + O_MZ + h * 192;
#pragma unroll
            for (int j = 0; j < 3; ++j) { const int vi = lane + 64 * j; const float z = bf2f(zp[vi]);
                zp[vi] = (bf16_t)f2bf((hv[j] * rs * nw[vi] + sk[vi] * XC[t * 192 + vi]) * silu_f(z)); } }
        __syncthreads();
    }
}

__device__ __forceinline__ void phase_mixers(Ctx& F, int l) {
    constexpr int N_ML = BATCH * 4, N_HG = BATCH * 6, N_XA = BATCH * 4 * (SEQ / 256);
    volatile LAS int* nxt = (volatile LAS int*)(F.lds + MISC_OFF);
    {
        unsigned* ctr = F_ctl + CW_QUEUE + 128 * l;
        for (;;) {
            __syncthreads();
            if (F.tid == 0) *nxt = (int)atomicAdd(ctr, 1u);
            __syncthreads();
            const int it = __builtin_amdgcn_readfirstlane(*nxt);
            if (it >= N_ML + N_HG) break;
            if (it < N_ML) mlstm_item(F, l, it >> 2, it & 3);
            else { const int r = it - N_ML; hgrn_item(F, l, r / 6, r % 6); }
        }
    }
    {
        unsigned* ctr = F_ctl + CW_QUEUE + 128 * l + 64;
        for (;;) {
            __syncthreads();
            if (F.tid == 0) *nxt = (int)atomicAdd(ctr, 1u);
            __syncthreads();
            const int u = __builtin_amdgcn_readfirstlane(*nxt);
            if (u >= N_XA) break;
            const int qt = u & 7, h = (u >> 3) & 3, b = u >> 5;
            const size_t qrow = (size_t)b * SEQ + qt * 256;
            const bf16_t* Kh = F_mkv + (size_t)(b * MEM_LEN) * 2048 + l * 1024 + h * 128;
            xattn::attn_body((const xattn::bf16*)(F_proj + qrow * P_IN + O_AQ + h * 128), (const xattn::bf16*)Kh, (const xattn::bf16*)(Kh + 512),
                             F_proj + qrow * P_IN + O_AZ + h * 128, F_xa_norm_w + l * 128, MEM_LEN, (char*)(unsigned char*)F.lds);
        }
    }
}

__device__ __forceinline__ void phase_final(Ctx& F) {
    const int gw = blockIdx.x * 8 + F.wave, NGW = F.G * 8;
    for (int row = gw; row < M_TOK; row += NGW) {
        f32x4* p = (f32x4*)(F.out + (size_t)row * D_MODEL) + F.lane; const f32x4* w = (const f32x4*)F_final_w + F.lane;
        const float rs = rsqrtf(F_ss2[row] * (1.0f / 1024.0f) + EPS);
#pragma unroll
        for (int j = 0; j < 4; ++j) p[64 * j] = p[64 * j] * rs * w[64 * j];
    }
}

constexpr int N_PHASES = 10;
__global__ void __launch_bounds__(512, 2) fwd_kernel(Params P) {
    extern __shared__ __attribute__((aligned(16))) unsigned char lds_raw[];
    Ctx F;
    F.lds = (LAS unsigned char*)lds_raw; F.tid = threadIdx.x; F.lane = F.tid & 63; F.wave = __builtin_amdgcn_readfirstlane(F.tid >> 6); F.G = gridDim.x;
    F.inp = P.in; F.out = P.out; F.ws = P.ws;
    const int lo = P.ph_lo, hi = P.ph_hi;
#define IN(k) (lo <= (k) && (k) < hi)
#if MK_SINGLE
#define SEAM(k) do { if (IN(k) && IN((k) + 1)) { cg::this_grid().sync(); } } while (0)
#else
#define SEAM(k) do { } while (0)
#endif
    if (IN(0)) { phase_prep(F); }
    SEAM(0);
    if (IN(1)) {
        { pg8::Gemm g{F_memb, F_WkvT, M_MEM, 2048, D_MODEL, D_MODEL}; pg8::StaticOrder S; S.init(M_MEM, 2048, F.G, (int)blockIdx.x);
          pg8::EpiScaleBf16 E{F_mkv, 2048, F_ssm};
          pg8::gemm_phase<pg8::EpiScaleBf16, pg8::StaticOrder, true, true>(F.lds, g, S, E); }
        { pg8::Gemm g{F_xb, F_WinT, M_TOK, P_IN, D_MODEL, D_MODEL}; pg8::StaticOrder S; S.init(M_TOK, P_IN, F.G, (int)blockIdx.x);
          pg8::EpiScaleBf16 E{F_proj, P_IN, F_ss0};
          pg8::gemm_phase<pg8::EpiScaleBf16, pg8::StaticOrder, true, true>(F.lds, g, S, E); }
    }
    SEAM(1);
    if (IN(2)) phase_gates(F, 0);
    SEAM(2);
    if (IN(3)) phase_mixers(F, 0);
    SEAM(3);
    if (IN(4)) { pg8::Gemm g{F_proj, F_WoutT, M_TOK, D_MODEL, D_MIX, P_IN}; pg8::StaticOrder S; S.init(M_TOK, D_MODEL, F.G, (int)blockIdx.x);
        pg8::EpiResid E{F_x, F.out, F_xb, F_ss1};
        pg8::gemm_phase<pg8::EpiResid, pg8::StaticOrder, true, true>(F.lds, g, S, E); }
    SEAM(4);
    if (IN(5)) { pg8::Gemm g{F_xb, F_WinT + (size_t)P_IN * D_MODEL, M_TOK, P_IN, D_MODEL, D_MODEL}; pg8::StaticOrder S; S.init(M_TOK, P_IN, F.G, (int)blockIdx.x);
        pg8::EpiScaleBf16 E{F_proj, P_IN, F_ss1};
        pg8::gemm_phase<pg8::EpiScaleBf16, pg8::StaticOrder, true, true>(F.lds, g, S, E); }
    SEAM(5);
    if (IN(6)) phase_gates(F, 1);
    SEAM(6);
    if (IN(7)) phase_mixers(F, 1);
    SEAM(7);
    if (IN(8)) { pg8::Gemm g{F_proj, F_WoutT + (size_t)D_MODEL * D_MIX, M_TOK, D_MODEL, D_MIX, P_IN}; pg8::StaticOrder S; S.init(M_TOK, D_MODEL, F.G, (int)blockIdx.x);
        pg8::EpiResid E{F.out, F.out, nullptr, F_ss2};
        pg8::gemm_phase<pg8::EpiResid, pg8::StaticOrder, true, true>(F.lds, g, S, E); }
    SEAM(8);
    if (IN(9)) phase_final(F);
#undef IN
#undef SEAM
}

extern "C" void kernel_launch(void* const* d_in, const int* in_sizes, int n_in, void* d_out, int out_size, void* d_ws, size_t ws_size, hipStream_t stream) {
    static int grid = 0;
    if (grid == 0) {
        if (n_in != 20 || in_sizes[0] != M_TOK * D_MODEL || out_size != M_TOK * D_MODEL || ws_size < WS_END) {
            fprintf(stderr, "kernel_launch: unexpected shapes: n_in %d in0 %d out %d ws %zu (need >= %zu)\n", n_in, n_in > 0 ? in_sizes[0] : -1, out_size, ws_size, (size_t)WS_END); grid = -1; return; }
        int dev = 0, cus = 0, per_cu = 0;
        if (hipGetDevice(&dev) != hipSuccess || hipDeviceGetAttribute(&cus, hipDeviceAttributeMultiprocessorCount, dev) != hipSuccess) { fprintf(stderr, "kernel_launch: device query failed\n"); grid = -1; return; }
        if (hipFuncSetAttribute((const void*)fwd_kernel, hipFuncAttributeMaxDynamicSharedMemorySize, LDS_BYTES) != hipSuccess) { fprintf(stderr, "kernel_launch: hipFuncSetAttribute failed\n"); grid = -1; return; }
        if (hipOccupancyMaxActiveBlocksPerMultiprocessor(&per_cu, (const void*)fwd_kernel, 512, LDS_BYTES) != hipSuccess || per_cu < 1) { fprintf(stderr, "kernel_launch: occupancy query says %d\n", per_cu); per_cu = 1; }
        (void)hipGetLastError();
        grid = cus;
        fprintf(stderr, "kernel_launch: grid %d (cus %d, occupancy %d/CU)\n", grid, cus, per_cu);
    }
    if (grid < 0) return;
    hipMemsetAsync((char*)d_ws + WS_CTL, 0, CTL_ZERO_BYTES, stream);
    Params p{};
    for (int i = 0; i < 20; ++i) p.in[i] = (const float*)d_in[i];
    p.out = (float*)d_out; p.ws = (unsigned char*)d_ws;
#if MK_SINGLE
    p.ph_lo = 0; p.ph_hi = N_PHASES;
    void* args[] = {&p};
    hipError_t e = hipLaunchCooperativeKernel((const void*)fwd_kernel, dim3(grid), dim3(512), args, LDS_BYTES, stream);
    if (e != hipSuccess) fprintf(stderr, "cooperative launch failed: %s (grid %d)\n", hipGetErrorString(e), grid);
#else
    for (int ph = 0; ph < N_PHASES; ++ph) {
        p.ph_lo = ph; p.ph_hi = ph + 1;
        hipLaunchKernelGGL(fwd_kernel, dim3(grid), dim3(512), LDS_BYTES, stream, p);
    }
    const hipError_t le = hipPeekAtLastError();
    if (le != hipSuccess) fprintf(stderr, "kernel_launch: launch failed: %s\n", hipGetErrorName(le));
#endif
}
```

```cpp
#include <hip/hip_runtime.h>
#include <hip/hip_cooperative_groups.h>
#include <hip/hip_bf16.h>
#include <cstdio>
#include <cstdint>
namespace cg = cooperative_groups;

#ifndef MK_SINGLE
#define MK_SINGLE 1
#endif

#define LAS __attribute__((address_space(3)))
typedef unsigned short bf16_t;
typedef short bf16x8 __attribute__((ext_vector_type(8)));
typedef float f32x4 __attribute__((ext_vector_type(4)));
typedef unsigned u32x4 __attribute__((ext_vector_type(4)));
typedef unsigned u32x2 __attribute__((ext_vector_type(2)));

constexpr int D_MODEL = 1024, BATCH = 32, SEQ = 2048, DEPTH = 2, MEM_LEN = 256, D_MIX = 2048;
constexpr int M_TOK = BATCH * SEQ;
constexpr int M_MEM = BATCH * MEM_LEN;
constexpr int P_IN = 5632;
constexpr float EPS = 1e-6f;
constexpr int O_HG = 0, O_MZ = 768, O_AZ = 1536, O_HQ = 2048, O_HF = 2816, O_HI = 3584, O_MX = 4352, O_AQ = 5120;
__host__ __device__ __forceinline__ int src_col(int n) {
    if (n < 768) return 2304 + n;
    if (n < 1536) return 3840 + (n - 768);
    if (n < 2048) return 5120 + (n - 1536);
    if (n < 2816) return n - 2048;
    if (n < 3584) return 768 + (n - 2816);
    if (n < 4352) return 1536 + (n - 3584);
    if (n < 5120) return 3072 + (n - 4352);
    return 4608 + (n - 5120);
}

constexpr size_t MiB = 1u << 20;
constexpr size_t WS_CTL = 0, CTL_ZERO_BYTES = 64 * 1024;
constexpr size_t WS_WIN = 2 * MiB;
constexpr size_t WS_WKV = 24 * MiB;
constexpr size_t WS_WOUT = 28 * MiB;
constexpr size_t WS_SS0 = 36 * MiB;
constexpr size_t WS_SS1 = WS_SS0 + 256 * 1024;
constexpr size_t WS_SS2 = WS_SS1 + 256 * 1024;
constexpr size_t WS_SSM = WS_SS2 + 256 * 1024;
constexpr size_t WS_LB = WS_SSM + 64 * 1024;
constexpr size_t WS_G12 = WS_LB + 8 * 1024;
constexpr size_t WS_GATES = 38 * MiB;
constexpr size_t WS_MEMB = 40 * MiB;
constexpr size_t WS_MKV = 56 * MiB;
constexpr size_t WS_XB = 88 * MiB;
constexpr size_t WS_PROJ = 216 * MiB;
constexpr size_t WS_XC = 920 * MiB;
constexpr size_t WS_END = 1016 * MiB;
constexpr int CW_BAR = 4096;
constexpr int CW_QUEUE = 1024;

constexpr int RING_BYTES = 131072;
constexpr int LDS_BYTES = 163840;
constexpr int MISC_OFF = LDS_BYTES - 256;
constexpr int SCAN_LDS = MISC_OFF;

__device__ __forceinline__ float bf2f(bf16_t v) { return __uint_as_float((unsigned)v << 16); }
__device__ __forceinline__ unsigned f2bf(float f) { unsigned u = __float_as_uint(f); return (u + 0x7fffu + ((u >> 16) & 1u)) >> 16; }
__device__ __forceinline__ unsigned pk2(float lo, float hi) { return f2bf(lo) | (f2bf(hi) << 16); }
__device__ __forceinline__ float rcp_f(float x) { return __builtin_amdgcn_rcpf(x); }
__device__ __forceinline__ float silu_f(float x) { return x * rcp_f(1.f + __expf(-x)); }
__device__ __forceinline__ float wave_sum(float v) {
#pragma unroll
    for (int o = 1; o < 64; o <<= 1) v += __shfl_xor(v, o);
    return v;
}

template <int K> __device__ __forceinline__ float swz_xor(float v) { return __builtin_bit_cast(float, __builtin_amdgcn_ds_swizzle(__builtin_bit_cast(int, v), 0x1f | (K << 10))); }

namespace pg8 {
constexpr int BM = 256, BK = 64, HALF = 128, HTB = HALF * BK * 2, STAGE_BYTES = 8 * HTB, NXCD = 8, WGM = 8;
__host__ __device__ __forceinline__ int lds_byte(int r, int c) { const int st = (r >> 4) * 2 + (c >> 5), rr = r & 15, cc = c & 31, ob = rr * 64 + cc * 2; return st * 1024 + (ob ^ (((ob >> 9) & 1) << 5)); }
__host__ __device__ __forceinline__ void stage_rc(int b, int& R, int& C) { const int st = b / 1024, sb = b % 1024, swz = sb ^ (((sb >> 9) & 1) << 5); R = (st >> 1) * 16 + swz / 64; C = (st & 1) * 32 + (swz % 64) / 2; }
__host__ __device__ __forceinline__ int perm32(int rho) { const int n = rho >> 4, i = rho & 15; return 8 * (i >> 2) + 4 * n + (i & 3); }

struct Unit { int pm, pn; };
struct Gemm { const bf16_t* A; const bf16_t* Bt; int M, N, K, lda; };

struct StaticOrder {
    int nM, nN, nwg, G, c;
    __host__ __device__ void init(int M, int N, int G_, int c_) { nM = M / BM; nN = N / BM; nwg = nM * nN; G = G_; c = c_; }
    __host__ __device__ bool next(int i, Unit& u) const {
        const long L = (long)i * G + c; if (L >= nwg) return false;
        int wgid = (int)L; { const int q = nwg / NXCD, r = nwg % NXCD, xcd = wgid % NXCD, off = wgid / NXCD; wgid = (xcd < r ? xcd * (q + 1) : r * (q + 1) + (xcd - r) * q) + off; }
        const int nig = WGM * nN, gid = wgid / nig, fm = gid * WGM, gsz = (nM - fm) < WGM ? (nM - fm) : WGM;
        u.pm = fm + ((wgid % nig) % gsz); u.pn = (wgid % nig) / gsz; return true;
    }
    __device__ __forceinline__ void a_ready(const Unit&) const {}
    __device__ __forceinline__ void done(const Unit&) const {}
};

__device__ __forceinline__ unsigned cvt_pk_bf16(float lo, float hi) { unsigned r; asm volatile("v_cvt_pk_bf16_f32 %0, %1, %2" : "=v"(r) : "v"(lo), "v"(hi)); return r; }

struct EpiScaleBf16 {
    static constexpr bool PERM = true, AFTER_DRAIN = false;
    bf16_t* O; int ldc; const float* ss;
    __device__ __forceinline__ void operator()(const f32x4 (&acc)[2][2][4][2], const Unit& u, int wr, int wc, int fr, int fq) const {
        const int row0 = u.pm * BM + wr * 64 + fr; const int col0 = u.pn * BM + wc * 32 + 8 * fq;
#pragma unroll
        for (int ai = 0; ai < 2; ++ai)
#pragma unroll
            for (int m = 0; m < 4; ++m) { const int row = row0 + ai * HALF + m * 16; const float sc = rsqrtf(ss[row] * (1.0f / 1024.0f) + EPS);
                bf16_t* rowp = O + (size_t)row * ldc + col0;
#pragma unroll
                for (int bj = 0; bj < 2; ++bj) { const f32x4 v0 = acc[ai][bj][m][0] * sc, v1 = acc[ai][bj][m][1] * sc;
                    u32x4 w; w.x = cvt_pk_bf16(v0[0], v0[1]); w.y = cvt_pk_bf16(v0[2], v0[3]); w.z = cvt_pk_bf16(v1[0], v1[1]); w.w = cvt_pk_bf16(v1[2], v1[3]);
                    *(u32x4*)(rowp + bj * HALF) = w; } }
    }
};
struct EpiProj {
    static constexpr bool PERM = true, AFTER_DRAIN = false;
    bf16_t* O; const float* ss; const float* lb;
    __device__ __forceinline__ void operator()(const f32x4 (&acc)[2][2][4][2], const Unit& u, int wr, int wc, int fr, int fq) const {
        const int row0 = u.pm * BM + wr * 64 + fr; const int colt = u.pn * BM; const int col0 = colt + wc * 32 + 8 * fq;
        const int kind = colt < O_HQ ? 0 : (colt < O_HF ? 1 : (colt < O_HI ? 2 : 3));
        f32x4 lbv[2][2];
        if (kind == 2) {
#pragma unroll
            for (int bj = 0; bj < 2; ++bj)
#pragma unroll
                for (int n = 0; n < 2; ++n) lbv[bj][n] = *(const f32x4*)(lb + (col0 - O_HF) + bj * HALF + 4 * n);
        }
#pragma unroll
        for (int ai = 0; ai < 2; ++ai)
#pragma unroll
            for (int m = 0; m < 4; ++m) { const int row = row0 + ai * HALF + m * 16; const float sc = rsqrtf(ss[row] * (1.0f / 1024.0f) + EPS);
                bf16_t* rowp = O + (size_t)row * P_IN + col0;
#pragma unroll
                for (int bj = 0; bj < 2; ++bj) { f32x4 v0 = acc[ai][bj][m][0] * sc, v1 = acc[ai][bj][m][1] * sc;
                    if (kind == 0) {
#pragma unroll
                        for (int i = 0; i < 4; ++i) { v0[i] = v0[i] * __builtin_amdgcn_rcpf(1.f + __expf(-v0[i])); v1[i] = v1[i] * __builtin_amdgcn_rcpf(1.f + __expf(-v1[i])); }
                    } else if (kind == 1) {
#pragma unroll
                        for (int i = 0; i < 4; ++i) { v0[i] = v0[i] * 0.08838834764831845f * __builtin_amdgcn_rcpf(1.f + __expf(-v0[i])); v1[i] = v1[i] * 0.08838834764831845f * __builtin_amdgcn_rcpf(1.f + __expf(-v1[i])); }
                    } else if (kind == 2) {
#pragma unroll
                        for (int i = 0; i < 4; ++i) {
                            { const float f = v0[i], lbx = lbv[bj][0][i]; const float e1 = __expf(-fabsf(f)), inv = __builtin_amdgcn_rcpf(1.f + e1); const float sg = f >= 0.f ? inv : e1 * inv; const float ls = fminf(f, 0.f) - __logf(1.f + e1);
                              v0[i] = (lbx == 0.f ? ls : __logf(lbx + (1.f - lbx) * sg)) * 1.4426950408889634f; }
                            { const float f = v1[i], lbx = lbv[bj][1][i]; const float e1 = __expf(-fabsf(f)), inv = __builtin_amdgcn_rcpf(1.f + e1); const float sg = f >= 0.f ? inv : e1 * inv; const float ls = fminf(f, 0.f) - __logf(1.f + e1);
                              v1[i] = (lbx == 0.f ? ls : __logf(lbx + (1.f - lbx) * sg)) * 1.4426950408889634f; } }
                    }
                    u32x4 w; w.x = cvt_pk_bf16(v0[0], v0[1]); w.y = cvt_pk_bf16(v0[2], v0[3]); w.z = cvt_pk_bf16(v1[0], v1[1]); w.w = cvt_pk_bf16(v1[2], v1[3]);
                    *(u32x4*)(rowp + bj * HALF) = w; } }
    }
};
template <bool FIRST> struct EpiResid {
    static constexpr bool PERM = true, AFTER_DRAIN = false;
    const float* xin; float* xout; bf16_t* xb; float* ss;
    __device__ __forceinline__ void operator()(const f32x4 (&acc)[2][2][4][2], const Unit& u, int wr, int wc, int fr, int fq) const {
        const int row0 = u.pm * BM + wr * 64 + fr; const int col0 = u.pn * BM + wc * 32 + 8 * fq;
#pragma unroll
        for (int ai = 0; ai < 2; ++ai)
#pragma unroll
            for (int m = 0; m < 4; ++m) { const int row = row0 + ai * HALF + m * 16; float s = 0.f;
#pragma unroll
                for (int bj = 0; bj < 2; ++bj) { const size_t off = (size_t)row * D_MODEL + col0 + bj * HALF;
                    f32x4 v0, v1;
                    { const u32x4 w = *(const u32x4*)(xb + off);
                        v0 = (f32x4){__uint_as_float(w.x << 16), __uint_as_float(w.x & 0xffff0000u), __uint_as_float(w.y << 16), __uint_as_float(w.y & 0xffff0000u)} + acc[ai][bj][m][0];
                        v1 = (f32x4){__uint_as_float(w.z << 16), __uint_as_float(w.z & 0xffff0000u), __uint_as_float(w.w << 16), __uint_as_float(w.w & 0xffff0000u)} + acc[ai][bj][m][1]; }
                    s += (v0[0] * v0[0] + v0[1] * v0[1]) + (v0[2] * v0[2] + v0[3] * v0[3]) + (v1[0] * v1[0] + v1[1] * v1[1]) + (v1[2] * v1[2] + v1[3] * v1[3]);
                    { u32x4 w; w.x = cvt_pk_bf16(v0[0], v0[1]); w.y = cvt_pk_bf16(v0[2], v0[3]); w.z = cvt_pk_bf16(v1[0], v1[1]); w.w = cvt_pk_bf16(v1[2], v1[3]); *(u32x4*)(xb + off) = w; } }
                s += __shfl_xor(s, 16); s += __shfl_xor(s, 32);
                if (fq == 0) atomicAdd(ss + row, s); }
    }
};

template <class Epi, class Sched, bool ALIGN_EPI = false, bool SP2 = false>
__device__ __forceinline__ void gemm_phase(LAS unsigned char* lds, const Gemm g, const Sched& S, const Epi& E) {
    const int tid = threadIdx.x, wid = __builtin_amdgcn_readfirstlane(tid >> 6), lane = tid & 63, wr = wid >> 2, wc = wid & 3, fr = lane & 15, fq = lane >> 4;
    const int K = g.K, nt = K / BK, lda = g.lda;
    unsigned voffA[2], voffB[2];
#pragma unroll
    for (int i = 0; i < 2; ++i) { int R, C; stage_rc(tid * 16 + i * 8192, R, C); const int Rb = Epi::PERM ? ((R & ~31) + perm32(R & 31)) : R;
        voffA[i] = (unsigned)(R * lda + C) * 2u; voffB[i] = (unsigned)(Rb * K + C) * 2u; }
    const size_t kstep = (size_t)(BK * 2);
    const size_t hstepA = (size_t)HALF * lda * 2, hstepB = (size_t)HALF * K * 2;
    const size_t tstepA = 2 * hstepA, tstepB = 2 * hstepB;
    const unsigned ldsw = (unsigned)wid * 1024u;
    const int aoff = lds_byte(wr * 64 + fr, fq * 8), boff = lds_byte(wc * 32 + fr, fq * 8);
#define PG8_SA(b, h) (((b) * 2 + (h)) * HTB)
#define PG8_SB(b, h) ((4 + (b) * 2 + (h)) * HTB)
#define PG8_STAGE(bufoff, gbase, voff) do { _Pragma("unroll") for (int _i = 0; _i < 2; ++_i) \
        __builtin_amdgcn_global_load_lds((const unsigned*)((const char*)(gbase) + (voff)[_i]), (LAS unsigned*)(lds + (bufoff) + ldsw + _i * 8192), 16, 0, 0); } while (0)
#define PG8_LDA(dst, b, h) do { _Pragma("unroll") for (int m = 0; m < 4; ++m) _Pragma("unroll") for (int k = 0; k < 2; ++k) dst[m][k] = *(const LAS bf16x8*)(lds + PG8_SA(b, h) + aoff + m * 2048 + k * 1024); } while (0)
#define PG8_LDB(dst, b, h) do { _Pragma("unroll") for (int n = 0; n < 2; ++n) _Pragma("unroll") for (int k = 0; k < 2; ++k) dst[n][k] = *(const LAS bf16x8*)(lds + PG8_SB(b, h) + boff + n * 2048 + k * 1024); } while (0)
#define PG8_MMA(ai, bj, At, Bt) do { __builtin_amdgcn_s_setprio(1); _Pragma("unroll") for (int m = 0; m < 4; ++m) _Pragma("unroll") for (int n = 0; n < 2; ++n) _Pragma("unroll") for (int k = 0; k < 2; ++k) \
        acc[ai][bj][m][n] = __builtin_amdgcn_mfma_f32_16x16x32_bf16(Bt[n][k], At[m][k], acc[ai][bj][m][n], 0, 0, 0); __builtin_amdgcn_s_setprio(0); } while (0)
#define PG8_WAIT_V(n) asm volatile("s_waitcnt vmcnt(" #n ")" ::: "memory")
#define PG8_WAIT_L(n) asm volatile("s_waitcnt lgkmcnt(" #n ")" ::: "memory")
#define PG8_BAR __builtin_amdgcn_s_barrier()
#define PG8_SCHED __builtin_amdgcn_sched_barrier(0)
    Unit cur, nxt; int ui = 0;
    if (!S.next(0, cur)) return;
    f32x4 acc[2][2][4][2];
#pragma unroll
    for (int a = 0; a < 2; ++a)
#pragma unroll
        for (int b = 0; b < 2; ++b)
#pragma unroll
            for (int m = 0; m < 4; ++m)
#pragma unroll
                for (int n = 0; n < 2; ++n) acc[a][b][m][n] = (f32x4){0.f, 0.f, 0.f, 0.f};
    bf16x8 At[4][2], B0[2][2], B1[2][2];
    const char* cA = (const char*)g.A + (size_t)cur.pm * tstepA; const char* cB = (const char*)g.Bt + (size_t)cur.pn * tstepB;
    S.a_ready(cur);
    if constexpr (SP2) {
        PG8_STAGE(PG8_SB(0, 0), cB, voffB); PG8_STAGE(PG8_SB(0, 1), cB + hstepB, voffB); PG8_STAGE(PG8_SA(0, 0), cA, voffA); PG8_STAGE(PG8_SA(0, 1), cA + hstepA, voffA);
        if (wr == 1) PG8_BAR;
        PG8_WAIT_V(2); PG8_BAR;
        PG8_STAGE(PG8_SB(1, 0), cB + kstep, voffB); PG8_STAGE(PG8_SA(1, 0), cA + kstep, voffA); PG8_STAGE(PG8_SB(1, 1), cB + hstepB + kstep, voffB);
        PG8_WAIT_V(6); PG8_BAR;
    } else {
        PG8_STAGE(PG8_SB(0, 0), cB, voffB); PG8_STAGE(PG8_SA(0, 0), cA, voffA); PG8_STAGE(PG8_SB(0, 1), cB + hstepB, voffB); PG8_STAGE(PG8_SA(0, 1), cA + hstepA, voffA);
        if (wr == 1) PG8_BAR;
        PG8_WAIT_V(4); PG8_BAR;
        PG8_STAGE(PG8_SB(1, 0), cB + kstep, voffB); PG8_STAGE(PG8_SA(1, 0), cA + kstep, voffA); PG8_STAGE(PG8_SB(1, 1), cB + hstepB + kstep, voffB);
        PG8_WAIT_V(6); PG8_BAR;
    }
    for (;;) {
        const bool has_next = S.next(ui + 1, nxt);
        const char* nA = has_next ? (const char*)g.A + (size_t)nxt.pm * tstepA : cA; const char* nB = has_next ? (const char*)g.Bt + (size_t)nxt.pn * tstepB : cB;
        for (int t = 0; t < nt; t += 2) {
            const bool last = (t == nt - 2);
            const char* a1 = cA + (size_t)(t + 1) * kstep;
            const char* a2 = last ? nA : cA + (size_t)(t + 2) * kstep; const char* b2 = last ? nB : cB + (size_t)(t + 2) * kstep;
            const char* a3 = a2 + kstep; const char* b3 = b2 + kstep;
            if (last && has_next) S.a_ready(nxt);
            if constexpr (SP2) {
            PG8_LDB(B0, 0, 0); PG8_LDB(B1, 0, 1); PG8_SCHED; PG8_LDA(At, 0, 0); PG8_STAGE(PG8_SA(1, 1), a1 + hstepA, voffA);
            PG8_WAIT_V(8); PG8_WAIT_L(0); PG8_BAR; PG8_MMA(0, 0, At, B0); PG8_MMA(0, 1, At, B1); PG8_BAR; PG8_SCHED;
            PG8_LDA(At, 0, 1); PG8_STAGE(PG8_SB(0, 0), b2, voffB); PG8_STAGE(PG8_SB(0, 1), b2 + hstepB, voffB); PG8_STAGE(PG8_SA(0, 0), a2, voffA);
            PG8_WAIT_V(8); PG8_WAIT_L(0); PG8_BAR; PG8_MMA(1, 0, At, B0); PG8_MMA(1, 1, At, B1); PG8_BAR; PG8_SCHED;
            PG8_LDB(B0, 1, 0); PG8_LDB(B1, 1, 1); PG8_SCHED; PG8_LDA(At, 1, 0); PG8_STAGE(PG8_SA(0, 1), a2 + hstepA, voffA);
            PG8_WAIT_V(8); PG8_WAIT_L(0); PG8_BAR; PG8_MMA(0, 0, At, B0); PG8_MMA(0, 1, At, B1); PG8_BAR; PG8_SCHED;
            PG8_LDA(At, 1, 1); PG8_STAGE(PG8_SB(1, 0), b3, voffB); PG8_STAGE(PG8_SB(1, 1), b3 + hstepB, voffB); PG8_STAGE(PG8_SA(1, 0), a3, voffA);
            PG8_WAIT_V(8); PG8_WAIT_L(0); PG8_BAR; PG8_MMA(1, 0, At, B0); PG8_MMA(1, 1, At, B1); PG8_BAR; PG8_SCHED;
            } else {
            PG8_LDB(B0, 0, 0); PG8_SCHED; PG8_LDA(At, 0, 0); PG8_STAGE(PG8_SA(1, 1), a1 + hstepA, voffA);
            PG8_WAIT_L(8); PG8_BAR; PG8_WAIT_L(0); PG8_MMA(0, 0, At, B0); PG8_BAR; PG8_SCHED;
            PG8_LDB(B1, 0, 1); PG8_STAGE(PG8_SB(0, 0), b2, voffB);
            PG8_BAR; PG8_WAIT_L(0); PG8_MMA(0, 1, At, B1); PG8_BAR;
            PG8_LDA(At, 0, 1); PG8_STAGE(PG8_SA(0, 0), a2, voffA);
            PG8_BAR; PG8_WAIT_L(0); PG8_MMA(1, 0, At, B0); PG8_BAR; PG8_SCHED;
            PG8_STAGE(PG8_SB(0, 1), b2 + hstepB, voffB);
            PG8_WAIT_V(6); PG8_BAR; PG8_MMA(1, 1, At, B1); PG8_BAR;
            PG8_LDB(B0, 1, 0); PG8_SCHED; PG8_LDA(At, 1, 0); PG8_STAGE(PG8_SA(0, 1), a2 + hstepA, voffA);
            PG8_WAIT_L(8); PG8_BAR; PG8_WAIT_L(0); PG8_MMA(0, 0, At, B0); PG8_BAR; PG8_SCHED;
            PG8_LDB(B1, 1, 1); PG8_STAGE(PG8_SB(1, 0), b3, voffB);
            PG8_BAR; PG8_WAIT_L(0); PG8_MMA(0, 1, At, B1); PG8_BAR;
            PG8_LDA(At, 1, 1); PG8_STAGE(PG8_SA(1, 0), a3, voffA);
            PG8_BAR; PG8_WAIT_L(0); PG8_MMA(1, 0, At, B0); PG8_BAR; PG8_SCHED;
            PG8_STAGE(PG8_SB(1, 1), b3 + hstepB, voffB);
            PG8_WAIT_V(6); PG8_BAR; PG8_MMA(1, 1, At, B1); PG8_BAR;
            }
        }
        if constexpr (ALIGN_EPI) { if (wr == 0) PG8_BAR; }
        if constexpr (!Epi::AFTER_DRAIN) { E(acc, cur, wr, wc, fr, fq); S.done(cur); }
        if (!has_next) break;
#pragma unroll
        for (int a = 0; a < 2; ++a)
#pragma unroll
            for (int b = 0; b < 2; ++b)
#pragma unroll
                for (int m = 0; m < 4; ++m)
#pragma unroll
                    for (int n = 0; n < 2; ++n) acc[a][b][m][n] = (f32x4){0.f, 0.f, 0.f, 0.f};
        cur = nxt; cA = nA; cB = nB; ++ui;
        if constexpr (ALIGN_EPI) { if (wr == 1) PG8_BAR; }
    }
    PG8_WAIT_V(0);
    if constexpr (!ALIGN_EPI) { if (wr == 0) PG8_BAR; }
    PG8_BAR;
#undef PG8_SA
#undef PG8_SB
#undef PG8_STAGE
#undef PG8_LDA
#undef PG8_LDB
#undef PG8_MMA
#undef PG8_WAIT_V
#undef PG8_WAIT_L
#undef PG8_BAR
#undef PG8_SCHED
}
}

namespace xattn {
using bf16 = __hip_bfloat16;
constexpr int D = 128, NW = 8, QBLK = 32, KVBLK = 64;
constexpr float SCALE = 0.088388347648318440f;
constexpr float THR = 8.f;
constexpr int SDEPTH = 1;
constexpr int LDQ = P_IN, LDK = 2048;
constexpr size_t SHM_V = KVBLK * D * 2, SHM_K = KVBLK * D * 2, SHM_ATTN = 2 * SHM_V + 2 * SHM_K + NW * 64 * 4;
using s16x4 = __attribute__((ext_vector_type(4))) short;
using f32x16 = __attribute__((ext_vector_type(16))) float;
#define KSWZ(row, colB) ((row) * 256 + ((colB) ^ (((row) & 7) << 4)))
#define SBAR() __builtin_amdgcn_sched_barrier(0)
__device__ __forceinline__ int crow(int r, int hi) { return (r & 3) + 8 * (r >> 2) + 4 * hi; }
__device__ __forceinline__ unsigned cvtpk(float lo, float hi) { unsigned r; asm volatile("v_cvt_pk_bf16_f32 %0, %1, %2" : "=v"(r) : "v"(lo), "v"(hi)); return r; }
__device__ __forceinline__ bf16x8 ld8(const bf16* p) { return *reinterpret_cast<const bf16x8*>(p); }

__device__ __forceinline__ void partialSM(f32x16& p0, f32x16& p1, float& m_reg, float& mn, float& alpha) {
  constexpr float C = SCALE * 1.4426950408889634f;
  float pmax = p0[0]; for (int r = 1; r < 16; ++r) pmax = fmaxf(pmax, p0[r]); for (int r = 0; r < 16; ++r) pmax = fmaxf(pmax, p1[r]);
  { auto rr = __builtin_amdgcn_permlane32_swap(__float_as_uint(pmax), __float_as_uint(pmax), false, false);
    pmax = fmaxf(__uint_as_float(rr[0]), __uint_as_float(rr[1])); }
  if (__builtin_expect(__all(pmax - m_reg <= THR / SCALE), 1)) { mn = m_reg; alpha = 1.f; }
  else { mn = fmaxf(m_reg, pmax); alpha = __builtin_amdgcn_exp2f((m_reg - mn) * C); m_reg = mn; }
  float mnC = -mn * C;
  for (int r = 0; r < 16; ++r) p0[r] = fmaf(p0[r], C, mnC); for (int r = 0; r < 16; ++r) p1[r] = fmaf(p1[r], C, mnC);
  for (int r = 0; r < 16; ++r) p0[r] = __builtin_amdgcn_exp2f(p0[r]);
}
__device__ __forceinline__ void finishSM(f32x16& p0, f32x16& p1, float alpha, float& l_reg, bf16x8& pa0, bf16x8& pa1, bf16x8& pa2, bf16x8& pa3) {
  for (int r = 0; r < 16; ++r) p1[r] = __builtin_amdgcn_exp2f(p1[r]);
  float ps = 0; for (int r = 0; r < 16; ++r) ps += p0[r]; for (int r = 0; r < 16; ++r) ps += p1[r];
  { auto rr = __builtin_amdgcn_permlane32_swap(__float_as_uint(ps), __float_as_uint(ps), false, false);
    ps = __uint_as_float(rr[0]) + __uint_as_float(rr[1]); }
  l_reg = l_reg * alpha + ps;
#define PK4(P, BASE, OUT) do { unsigned a0 = cvtpk(P[BASE + 0], P[BASE + 1]), a1 = cvtpk(P[BASE + 2], P[BASE + 3]);   \
    unsigned b0 = cvtpk(P[BASE + 4], P[BASE + 5]), b1 = cvtpk(P[BASE + 6], P[BASE + 7]);                              \
    auto r0 = __builtin_amdgcn_permlane32_swap(a0, b0, false, false); auto r1 = __builtin_amdgcn_permlane32_swap(a1, b1, false, false); \
    u32x4 w = {r0[0], r1[0], r0[1], r1[1]}; OUT = *reinterpret_cast<bf16x8*>(&w); } while (0)
  PK4(p0, 0, pa0); PK4(p0, 8, pa1); PK4(p1, 0, pa2); PK4(p1, 8, pa3);
#undef PK4
}
__device__ __forceinline__ void qkt(f32x16& p0, f32x16& p1, const bf16* Ks, const bf16x8* qr, int r32, int hi) {
  p0 = f32x16{}; p1 = f32x16{};
  for (int d0 = 0; d0 < 8; ++d0) { int cb = (d0 * 16 + hi * 8) * 2;
    bf16x8 b0 = *reinterpret_cast<const bf16x8*>((const char*)Ks + KSWZ(r32, cb));
    bf16x8 b1 = *reinterpret_cast<const bf16x8*>((const char*)Ks + KSWZ(32 + r32, cb));
    p0 = __builtin_amdgcn_mfma_f32_32x32x16_bf16(b0, qr[d0], p0, 0, 0, 0);
    p1 = __builtin_amdgcn_mfma_f32_32x32x16_bf16(b1, qr[d0], p1, 0, 0, 0); }
}
__device__ __forceinline__ int v_st(int k, int c) { const int kk = (k & ~0xC) | ((k & 4) << 1) | ((k & 8) >> 1); return ((kk >> 3) * 4 + (c >> 5)) * 512 + ((kk & 7) * 32 + (c & 31)) * 2; }
__device__ __forceinline__ int v_rd_base(int lane) { return ((lane & 3) << 3) | (((lane >> 2) & 3) << 6) | (((lane >> 4) & 1) << 5) | (((lane >> 5) & 1) << 8); }
constexpr int v_rd_off(int d0, int ks, int half) { return d0 * 512 + ks * 4096 + half * 2048; }
template <int OFF> __device__ __forceinline__ s16x4 tr_read(int vb) {
  s16x4 r; asm volatile("ds_read_b64_tr_b16 %0, %1 offset:%2" : "=&v"(r) : "v"(vb), "i"(OFF) : "memory"); return r;
}
template <int D0> __device__ __forceinline__ void pv_one(f32x16& od, int vb, bf16x8 pa0, bf16x8 pa1, bf16x8 pa2, bf16x8 pa3) {
  const s16x4 l0 = tr_read<v_rd_off(D0, 0, 0)>(vb), h0 = tr_read<v_rd_off(D0, 0, 1)>(vb), l1 = tr_read<v_rd_off(D0, 1, 0)>(vb), h1 = tr_read<v_rd_off(D0, 1, 1)>(vb);
  const s16x4 l2 = tr_read<v_rd_off(D0, 2, 0)>(vb), h2 = tr_read<v_rd_off(D0, 2, 1)>(vb), l3 = tr_read<v_rd_off(D0, 3, 0)>(vb), h3 = tr_read<v_rd_off(D0, 3, 1)>(vb);
  asm volatile("s_waitcnt lgkmcnt(0)" ::: "memory"); SBAR();
#define PK(L, H) (bf16x8){L[0], L[1], L[2], L[3], H[0], H[1], H[2], H[3]}
  od = __builtin_amdgcn_mfma_f32_32x32x16_bf16(pa0, PK(l0, h0), od, 0, 0, 0);
  od = __builtin_amdgcn_mfma_f32_32x32x16_bf16(pa1, PK(l1, h1), od, 0, 0, 0);
  od = __builtin_amdgcn_mfma_f32_32x32x16_bf16(pa2, PK(l2, h2), od, 0, 0, 0);
  od = __builtin_amdgcn_mfma_f32_32x32x16_bf16(pa3, PK(l3, h3), od, 0, 0, 0);
#undef PK
}
__device__ __forceinline__ void pv_d0(f32x16* o, int vb, bf16x8 pa0, bf16x8 pa1, bf16x8 pa2, bf16x8 pa3) {
  pv_one<0>(o[0], vb, pa0, pa1, pa2, pa3); pv_one<1>(o[1], vb, pa0, pa1, pa2, pa3); pv_one<2>(o[2], vb, pa0, pa1, pa2, pa3); pv_one<3>(o[3], vb, pa0, pa1, pa2, pa3);
}
constexpr int XA_V = 0, XA_K = 4 * (int)SHM_V, XA_WS = XA_K + 4 * (int)SHM_K, XA_ST = XA_WS + NW * 64 * 4, XA_END = XA_ST + NW * 2048;
template <int NQT>
__device__ __forceinline__ void attn_unit(const bf16* Qb, const bf16* Kh, const bf16* Vh, bf16_t* Gb, const float* nw, char* lds) {
  const int tid = threadIdx.x, wid = tid >> 6, lane = tid & 63, r32 = lane & 31, hi = lane >> 5;
  bf16* V_lds = (bf16*)(lds + XA_V); bf16* K_lds = (bf16*)(lds + XA_K);
  float* ws = (float*)(lds + XA_WS) + wid * 64; float* li_l = ws; float* al_l = ws + 32;
  char* stg = lds + XA_ST + wid * 2048;
  {
    const int sr = tid >> 4, sc = (tid & 15) * 8, vst0 = v_st(sr, sc), vst1 = v_st(32 + sr, sc), kc = sc * 2;
    bf16x8 vs[4][2], ks[4][2];
#pragma unroll
    for (int t = 0; t < 4; ++t) { vs[t][0] = ld8(&Vh[(long)(t * 64 + sr) * LDK + sc]); vs[t][1] = ld8(&Vh[(long)(t * 64 + 32 + sr) * LDK + sc]);
      ks[t][0] = ld8(&Kh[(long)(t * 64 + sr) * LDK + sc]); ks[t][1] = ld8(&Kh[(long)(t * 64 + 32 + sr) * LDK + sc]); }
#pragma unroll
    for (int t = 0; t < 4; ++t) { *(bf16x8*)((char*)V_lds + t * SHM_V + vst0) = vs[t][0]; *(bf16x8*)((char*)V_lds + t * SHM_V + vst1) = vs[t][1];
      *(bf16x8*)((char*)K_lds + t * SHM_K + KSWZ(sr, kc)) = ks[t][0]; *(bf16x8*)((char*)K_lds + t * SHM_K + KSWZ(32 + sr, kc)) = ks[t][1]; }
  }
  const int vb0 = (int)(uintptr_t)V_lds + v_rd_base(lane);
  bf16x8 qr[8];
  { const bf16* Qw = Qb + (long)(wid * QBLK + r32) * LDQ + hi * 8;
#pragma unroll
    for (int d0 = 0; d0 < 8; ++d0) qr[d0] = ld8(Qw + d0 * 16); }
  __syncthreads();
  float nwv[4];
#pragma unroll
  for (int d0 = 0; d0 < 4; ++d0) nwv[d0] = nw[d0 * 32 + r32];
#define RESC(a) do { if (__any((a) < 1.f)) { if (hi == 0) al_l[r32] = (a); asm volatile("s_waitcnt lgkmcnt(0)" ::: "memory"); \
    for (int d = 0; d < 4; ++d) for (int r = 0; r < 16; ++r) o[d][r] *= al_l[crow(r, hi)]; } } while (0)
#pragma unroll 1
  for (int qt = 0; qt < NQT; ++qt) {
    float m_reg = -1e30f, l_reg = 0; f32x16 o[4] = {};
    f32x16 pA0, pA1; float mnA, alA; bf16x8 pa0, pa1, pa2, pa3;
#pragma unroll
    for (int j = 0; j < 4; ++j) {
      SBAR(); qkt(pA0, pA1, (bf16*)((char*)K_lds + j * SHM_K), qr, r32, hi);
      if (j == 3 && qt + 1 < NQT) {
        const bf16* Qw = Qb + (long)((qt + 1) * 256 + wid * QBLK + r32) * LDQ + hi * 8;
#pragma unroll
        for (int d0 = 0; d0 < 8; ++d0) qr[d0] = ld8(Qw + d0 * 16); }
      partialSM(pA0, pA1, m_reg, mnA, alA); RESC(alA);
      finishSM(pA0, pA1, alA, l_reg, pa0, pa1, pa2, pa3); SBAR();
      pv_d0(o, vb0 + j * (int)SHM_V, pa0, pa1, pa2, pa3);
    }
    bf16_t* Gw = Gb + (long)(qt * 256 + wid * QBLK) * LDQ;
    u32x4 gt[4][2];
#pragma unroll
    for (int d0 = 0; d0 < 4; ++d0)
#pragma unroll
      for (int k = 0; k < 2; ++k) { const int id = lane + 64 * k; gt[d0][k] = *(const u32x4*)(Gw + (long)(id >> 2) * LDQ + d0 * 32 + (id & 3) * 8); }
    if (hi == 0) li_l[r32] = l_reg; asm volatile("s_waitcnt lgkmcnt(0)" ::: "memory");
    float ssq[16];
#pragma unroll
    for (int r = 0; r < 16; ++r) { const float rl = __builtin_amdgcn_rcpf(li_l[crow(r, hi)]); float sq = 0.f;
#pragma unroll
      for (int d0 = 0; d0 < 4; ++d0) { const float vv = o[d0][r] * rl; o[d0][r] = vv; sq += vv * vv; }
      sq += swz_xor<1>(sq); sq += swz_xor<2>(sq); sq += swz_xor<4>(sq); sq += swz_xor<8>(sq); sq += swz_xor<16>(sq); ssq[r] = rsqrtf(sq * (1.0f / 128.0f) + EPS); }
#pragma unroll
    for (int d0 = 0; d0 < 4; ++d0) {
#pragma unroll
      for (int r = 0; r < 16; ++r) *(unsigned short*)(stg + crow(r, hi) * 64 + r32 * 2) = (unsigned short)f2bf(o[d0][r] * ssq[r] * nwv[d0]);
      asm volatile("s_waitcnt lgkmcnt(0)" ::: "memory");
#pragma unroll
      for (int k = 0; k < 2; ++k) { const int id = lane + 64 * k; const u32x4 ov = *(const u32x4*)(stg + id * 16); const u32x4 g = gt[d0][k]; u32x4 w;
#pragma unroll
        for (int e = 0; e < 4; ++e) w[e] = pk2(__uint_as_float(ov[e] << 16) * __uint_as_float(g[e] << 16), __uint_as_float(ov[e] & 0xffff0000u) * __uint_as_float(g[e] & 0xffff0000u));
        *(u32x4*)(Gw + (long)(id >> 2) * LDQ + d0 * 32 + (id & 3) * 8) = w; }
      asm volatile("s_waitcnt lgkmcnt(0)" ::: "memory");
    }
  }
#undef RESC
}
#undef KSWZ
#undef SBAR
static_assert(XA_END <= SCAN_LDS, "xattn lds");
}

#define XB_TMO      128
#define XB_XCNT(j)  (256  + 64 * (j))
#define XB_XSUB(j)  (1280 + 64 * (j))
#define XB_XGEN(j)  (2304 + 64 * (j))
#define XB_TOP      3328
#define XB_TOPGEN   3392
#define XCD_BAR_WORDS 3456
#define XB_SPIN_CAP (1u << 22)
__device__ __forceinline__ unsigned xb_ld(unsigned* p)              { return __hip_atomic_load(p, __ATOMIC_RELAXED, __HIP_MEMORY_SCOPE_AGENT); }
__device__ __forceinline__ unsigned xb_add(unsigned* p, unsigned v) { return __hip_atomic_fetch_add(p, v, __ATOMIC_RELAXED, __HIP_MEMORY_SCOPE_AGENT); }
__device__ __forceinline__ unsigned xb_xcc_id() { return (unsigned)__builtin_amdgcn_s_getreg((3 << 11) | 20) & 0xFu; }
#define XB_SPIN(cond, bar) do { unsigned _sp = 0; while (cond) { __builtin_amdgcn_s_sleep(1); \
    if ((++_sp & 255u) == 0u) { if (xb_ld(&(bar)[XB_TMO])) break; if (_sp > XB_SPIN_CAP) { atomicAdd(&(bar)[XB_TMO], 1u); break; } } } } while (0)
struct XcdBarrier { unsigned* bar; unsigned x; volatile LAS unsigned* st; };
__device__ __forceinline__ XcdBarrier xcd_barrier_post(unsigned* bar, volatile LAS unsigned* st) {
    XcdBarrier b; b.bar = bar; b.x = xb_xcc_id(); b.st = st;
    if (threadIdx.x == 0) (void)xb_add(&bar[XB_XCNT(b.x)], 1u);
    return b;
}
__device__ __forceinline__ void xcd_barrier_complete(unsigned* bar, unsigned x, unsigned& nloc, unsigned& nx) {
    const unsigned G = gridDim.x * gridDim.y * gridDim.z;
    unsigned sum, cnt, mine, sp = 0u;
    for (;;) {
        sum = 0u; cnt = 0u; mine = 0u;
#pragma unroll
        for (unsigned j = 0; j < 16; ++j) { const unsigned c = xb_ld(&bar[XB_XCNT(j)]); sum += c; cnt += (c > 0u) ? 1u : 0u; mine = (j == x) ? c : mine; }
        if (sum == G) break;
        __builtin_amdgcn_s_sleep(1);
        if ((++sp & 255u) == 0u) { if (xb_ld(&bar[XB_TMO])) break; if (sp > XB_SPIN_CAP) { atomicAdd(&bar[XB_TMO], 1u); break; } }
    }
    nloc = mine > 0u ? mine : 1u; nx = cnt > 0u ? cnt : 1u;
}
__device__ __forceinline__ void xcd_barrier(const XcdBarrier& b) {
    asm volatile("s_waitcnt vmcnt(0)" ::: "memory");
    __syncthreads();
    if (threadIdx.x == 0) {
        unsigned* bar = b.bar;
        __builtin_amdgcn_s_waitcnt(0);
        unsigned nloc = b.st[0], nx = b.st[1];
        if (nloc == 0u) { xcd_barrier_complete(bar, b.x, nloc, nx); b.st[0] = nloc; b.st[1] = nx; }
        const unsigned old = xb_add(&bar[XB_XSUB(b.x)], 1u);
        const unsigned gen = old / nloc;
        if (old + 1u == (gen + 1u) * nloc) {
            __builtin_amdgcn_fence(__ATOMIC_RELEASE, "agent");
            asm volatile("s_waitcnt vmcnt(0)" ::: "memory");
            const unsigned og = xb_add(&bar[XB_TOP], 1u);
            const unsigned tg = og / nx;
            if (og + 1u == (tg + 1u) * nx) xb_add(&bar[XB_TOPGEN], 1u);
            else XB_SPIN(xb_ld(&bar[XB_TOPGEN]) == tg, bar);
            __builtin_amdgcn_fence(__ATOMIC_ACQUIRE, "agent");
            xb_add(&bar[XB_XGEN(b.x)], 1u);
            asm volatile("s_waitcnt vmcnt(0)" ::: "memory");
        } else {
            XB_SPIN(xb_ld(&bar[XB_XGEN(b.x)]) == gen, bar);
            __builtin_amdgcn_fence(__ATOMIC_ACQUIRE, "agent");
            asm volatile("s_waitcnt vmcnt(0)" ::: "memory");
        }
    }
    __syncthreads();
}

struct Params {
    const float* in[20]; float* out; unsigned char* ws; int ph_lo, ph_hi;
};
struct Ctx {
    LAS unsigned char* lds; int tid, lane, wave, G;
    const float* const* inp;
    float* out; unsigned char* ws;
};
#define F_IN(k) (F.inp[k])
#define F_x F_IN(0)
#define F_mem F_IN(1)
#define F_norm_w F_IN(2)
#define F_w_in F_IN(3)
#define F_lb_logits F_IN(4)
#define F_hgrn_norm_w F_IN(5)
#define F_conv_w F_IN(6)
#define F_conv_b F_IN(7)
#define F_wq F_IN(8)
#define F_wk F_IN(9)
#define F_wv F_IN(10)
#define F_w_gate F_IN(11)
#define F_b_gate F_IN(12)
#define F_ml_norm_w F_IN(13)
#define F_ml_skip F_IN(14)
#define F_mem_norm_w F_IN(15)
#define F_w_kv F_IN(16)
#define F_xa_norm_w F_IN(17)
#define F_w_out F_IN(18)
#define F_final_w F_IN(19)
#define F_ctl ((unsigned*)(F.ws + WS_CTL))
#define F_WinT ((bf16_t*)(F.ws + WS_WIN))
#define F_WkvT ((bf16_t*)(F.ws + WS_WKV))
#define F_WoutT ((bf16_t*)(F.ws + WS_WOUT))
#define F_memb ((bf16_t*)(F.ws + WS_MEMB))
#define F_mkv ((bf16_t*)(F.ws + WS_MKV))
#define F_xb ((bf16_t*)(F.ws + WS_XB))
#define F_proj ((bf16_t*)(F.ws + WS_PROJ))
#define F_ss0 ((float*)(F.ws + WS_SS0))
#define F_ss1 ((float*)(F.ws + WS_SS1))
#define F_ss2 ((float*)(F.ws + WS_SS2))
#define F_ssm ((float*)(F.ws + WS_SSM))
#define F_lb ((float*)(F.ws + WS_LB))
#define F_gates ((float*)(F.ws + WS_GATES))
#define F_g12 ((float*)(F.ws + WS_G12))
#define F_xcb ((bf16_t*)(F.ws + WS_XC))

__device__ __forceinline__ void transpose_item(const float* W, int ldw, int K, int k0, int nsrc, bf16_t* WT, int ndst, const float* kscale, LAS float* scr, int lane) {
    f32x4 v[8]; float sc[8];
#pragma unroll
    for (int i = 0; i < 8; ++i) { const int kk = 8 * i + (lane >> 3); v[i] = *(const f32x4*)(W + (size_t)(k0 + kk) * ldw + nsrc + 4 * (lane & 7)); sc[i] = kscale ? kscale[k0 + kk] : 1.f; }
#pragma unroll
    for (int i = 0; i < 8; ++i) { const int kk = 8 * i + (lane >> 3); LAS float* d = scr + kk * 33 + 4 * (lane & 7);
        d[0] = v[i][0] * sc[i]; d[1] = v[i][1] * sc[i]; d[2] = v[i][2] * sc[i]; d[3] = v[i][3] * sc[i]; }
    asm volatile("s_waitcnt lgkmcnt(0)" ::: "memory");
    const int c = lane & 7;
#pragma unroll
    for (int j = 0; j < 4; ++j) { const int n = (lane >> 3) + 8 * j; const LAS float* s = scr + (8 * c) * 33 + n;
        u32x4 o; o.x = pk2(s[0 * 33], s[1 * 33]); o.y = pk2(s[2 * 33], s[3 * 33]); o.z = pk2(s[4 * 33], s[5 * 33]); o.w = pk2(s[6 * 33], s[7 * 33]);
        *(u32x4*)(WT + (size_t)(ndst + n) * K + k0 + 8 * c) = o; }
    asm volatile("s_waitcnt lgkmcnt(0)" ::: "memory");
}

__device__ __forceinline__ void phase_prep(Ctx& F) {
    LAS float* scr = (LAS float*)(F.lds + F.wave * 16384);
    const int gw = blockIdx.x * 8 + F.wave, NGW = F.G * 8;
    constexpr int I_IN = DEPTH * 16 * 176, I_KV = DEPTH * 16 * 32, I_OUT = DEPTH * 32 * 32;
    for (int it = gw; it < I_IN + I_KV + I_OUT; it += NGW) {
        int r = it;
        if (r < I_IN) { const int l = r / (16 * 176), rr = r % (16 * 176), kb = rr / 176, nb = rr % 176;
            transpose_item(F_w_in + (size_t)l * D_MODEL * P_IN, P_IN, D_MODEL, kb * 64, src_col(nb * 32), F_WinT + (size_t)l * P_IN * D_MODEL, nb * 32, F_norm_w + l * D_MODEL, scr, F.lane); continue; }
        r -= I_IN;
        if (r < I_KV) { const int l = r / (16 * 32), rr = r % (16 * 32), kb = rr / 32, nb = rr % 32;
            transpose_item(F_w_kv + (size_t)l * D_MODEL * 1024, 1024, D_MODEL, kb * 64, nb * 32, F_WkvT + (size_t)l * 1024 * D_MODEL, nb * 32, F_mem_norm_w + l * D_MODEL, scr, F.lane); continue; }
        r -= I_KV;
        { const int l = r / (32 * 32), rr = r % (32 * 32), kb = rr / 32, nb = rr % 32;
            transpose_item(F_w_out + (size_t)l * D_MIX * D_MODEL, D_MODEL, D_MIX, kb * 64, nb * 32, F_WoutT + (size_t)l * D_MODEL * D_MIX, nb * 32, nullptr, scr, F.lane); }
    }
    for (int rb = gw * 4; rb < M_TOK + M_MEM; rb += NGW * 4) {
        f32x4 v[4][4];
#pragma unroll
        for (int q = 0; q < 4; ++q) { const int row = rb + q; const bool isx = row < M_TOK; const int r = isx ? row : row - M_TOK;
            const f32x4* src = (const f32x4*)((isx ? F_x : F_mem) + (size_t)r * D_MODEL) + F.lane;
#pragma unroll
            for (int j = 0; j < 4; ++j) v[q][j] = src[64 * j]; }
#pragma unroll
        for (int q = 0; q < 4; ++q) { const int row = rb + q; const bool isx = row < M_TOK; const int r = isx ? row : row - M_TOK;
            u32x2* dst = (u32x2*)((isx ? F_xb : F_memb) + (size_t)r * D_MODEL) + F.lane; float s = 0.f;
#pragma unroll
            for (int j = 0; j < 4; ++j) { s += (v[q][j][0] * v[q][j][0] + v[q][j][1] * v[q][j][1]) + (v[q][j][2] * v[q][j][2] + v[q][j][3] * v[q][j][3]);
                u32x2 w; w.x = pk2(v[q][j][0], v[q][j][1]); w.y = pk2(v[q][j][2], v[q][j][3]); dst[64 * j] = w; }
            s = wave_sum(s);
            if (F.lane == 0) (isx ? F_ss0 : F_ssm)[r] = s; }
    }
    const int gt = blockIdx.x * 512 + F.tid, NGT = F.G * 512;
    for (int i = gt; i < 2 * M_TOK; i += NGT) F_ss1[i] = 0.f;
    for (int i = gt; i < DEPTH * 768; i += NGT) {
        const int l = i / 768, c = i % 768, g = c >> 2, ii = c & 3;
        const float* wq = F_wq + (l * 192 + g) * 16 + ii * 4; const float* wk = F_wk + (l * 192 + g) * 16 + ii * 4; const float* wv = F_wv + (l * 192 + g) * 16 + ii * 4;
        const float* wg = F_w_gate + (size_t)l * 2304 * 8;
        float g1[8], g2[8];
#pragma unroll
        for (int n = 0; n < 8; ++n) { g1[n] = 0.f; g2[n] = 0.f; }
#pragma unroll
        for (int o = 0; o < 4; ++o)
#pragma unroll
            for (int n = 0; n < 8; ++n) { g1[n] += wq[o] * wg[(4 * g + o) * 8 + n] + wk[o] * wg[(768 + 4 * g + o) * 8 + n]; g2[n] += wv[o] * wg[(1536 + 4 * g + o) * 8 + n]; }
#pragma unroll
        for (int n = 0; n < 8; ++n) { F_g12[(size_t)i * 16 + n] = g1[n]; F_g12[(size_t)i * 16 + 8 + n] = g2[n]; }
    }
    for (int i = gt; i < 768; i += NGT) { const float l0 = F_lb_logits[i], l1 = F_lb_logits[768 + i]; const float mx = fmaxf(l0, l1);
        const float e0 = __expf(l0 - mx), e1 = __expf(l1 - mx); const float s0 = e0 / (e0 + e1), s1 = e1 / (e0 + e1);
        F_lb[i] = fmaxf(s0 - s0, 0.f); F_lb[768 + i] = fmaxf((s0 + s1) - s0, 0.f); }
}

constexpr int GXS = 1552, GTS = 3088;
constexpr int G_XT = 0, G_MT = G_XT + 32 * GXS, G_GT = G_MT + 32 * GXS, G_CW = G_GT + 9 * GTS, G_CB = G_CW + 4 * 768 * 4, G_RED = G_CB + 768 * 4, G_END = G_RED + 8 * 32 * 8 * 4;
static_assert(G_END <= MISC_OFF && (G_CW % 16) == 0, "gates lds");
__device__ __forceinline__ void phase_gates(Ctx& F, int l) {
    using f32x16 = __attribute__((ext_vector_type(16))) float;
    const int lane = F.lane, wave = F.wave, r32 = lane & 31, hh = lane >> 5;
    LAS unsigned char* L = F.lds;
    for (int i = F.tid; i < 768 * 4; i += 512) ((LAS float*)(L + G_CW))[i] = F_conv_w[l * 4 * 768 + i];
    for (int i = F.tid; i < 768; i += 512) ((LAS float*)(L + G_CB))[i] = F_conv_b[l * 768 + i];
    for (int i = F.tid; i < 9 * 1536; i += 512) { const int n = i / 1536, k = i % 1536;
        const float v = n < 8 ? F_g12[(size_t)l * 768 * 16 + (size_t)(k % 768) * 16 + (k / 768) * 8 + n] : 0.f;
        *(LAS unsigned short*)(L + G_GT + n * GTS + k * 2) = (unsigned short)f2bf(v); }
    __syncthreads();
    const float* bg = F_b_gate + l * 8;
    u32x2 xq[2][3][5];
#define G_LOAD(st_) do { _Pragma("unroll") for (int pr = 0; pr < 2; ++pr) { const int tok_ = 32 * (st_) + 2 * (wave + 8 * pr), t_ = tok_ & (SEQ - 1); \
        _Pragma("unroll") for (int gi = 0; gi < 3; ++gi) _Pragma("unroll") for (int j = 0; j < 5; ++j) \
        xq[pr][gi][j] = (t_ - 3 + j >= 0) ? *(const u32x2*)(F_proj + (size_t)(tok_ - 3 + j) * P_IN + O_MX + 4 * (lane + 64 * gi)) : (u32x2){0u, 0u}; } } while (0)
    const int NST = M_TOK / 32;
    if ((int)blockIdx.x < NST) G_LOAD(blockIdx.x);
#pragma unroll 1
    for (int st = blockIdx.x; st < NST; st += F.G) {
#pragma unroll
        for (int pr = 0; pr < 2; ++pr) {
            const int tl = 2 * (wave + 8 * pr), tok = 32 * st + tl;
#pragma unroll
            for (int gi = 0; gi < 3; ++gi) {
                const int c = 4 * (lane + 64 * gi);
                float x[5][4];
#pragma unroll
                for (int j = 0; j < 5; ++j) { const u32x2 w = xq[pr][gi][j];
                    x[j][0] = __uint_as_float(w.x << 16); x[j][1] = __uint_as_float(w.x & 0xffff0000u); x[j][2] = __uint_as_float(w.y << 16); x[j][3] = __uint_as_float(w.y & 0xffff0000u); }
                const f32x4 cbv = *(LAS const f32x4*)(L + G_CB + c * 4);
                f32x4 cw[4]; float xs0[4], xs1[4];
#pragma unroll
                for (int j = 0; j < 4; ++j) cw[j] = *(LAS const f32x4*)(L + G_CW + (j * 768 + c) * 4);
#pragma unroll
                for (int i = 0; i < 4; ++i) { float a0 = cbv[i], a1 = cbv[i];
#pragma unroll
                    for (int j = 0; j < 4; ++j) { a0 += cw[j][i] * x[j][i]; a1 += cw[j][i] * x[j + 1][i]; }
                    xs0[i] = a0 * rcp_f(1.f + __expf(-a0)); xs1[i] = a1 * rcp_f(1.f + __expf(-a1)); }
                const u32x2 w0 = {pk2(xs0[0], xs0[1]), pk2(xs0[2], xs0[3])}, w1 = {pk2(xs1[0], xs1[1]), pk2(xs1[2], xs1[3])};
                *(u32x2*)(F_xcb + (size_t)tok * 768 + c) = w0; *(u32x2*)(F_xcb + (size_t)(tok + 1) * 768 + c) = w1;
                *(LAS u32x2*)(L + G_XT + tl * GXS + c * 2) = w0; *(LAS u32x2*)(L + G_XT + (tl + 1) * GXS + c * 2) = w1;
                *(LAS u32x2*)(L + G_MT + tl * GXS + c * 2) = xq[pr][gi][3]; *(LAS u32x2*)(L + G_MT + (tl + 1) * GXS + c * 2) = xq[pr][gi][4];
                __builtin_amdgcn_sched_barrier(0);
            }
        }
        if (st + F.G < NST) G_LOAD(st + F.G);
        __syncthreads();
        {
            f32x16 acc = f32x16{};
            LAS const unsigned char* arow = L + (wave < 4 ? G_XT : G_MT) + r32 * GXS + ((wave & 3) * 192 + 8 * hh) * 2;
            LAS const unsigned char* brow = L + G_GT + (r32 < 8 ? r32 : 8) * GTS + (wave * 192 + 8 * hh) * 2;
#pragma unroll
            for (int ks = 0; ks < 12; ++ks)
                acc = __builtin_amdgcn_mfma_f32_32x32x16_bf16(*(LAS const bf16x8*)(arow + ks * 32), *(LAS const bf16x8*)(brow + ks * 32), acc, 0, 0, 0);
            if (r32 < 8) {
#pragma unroll
                for (int i = 0; i < 16; ++i) *(LAS float*)(L + G_RED + ((wave * 32 + (i & 3) + 8 * (i >> 2) + 4 * hh) * 8 + r32) * 4) = acc[i];
            }
        }
        __syncthreads();
        if (F.tid < 256) { const int tk = F.tid >> 3, n = F.tid & 7; float v = bg[n];
#pragma unroll
            for (int w = 0; w < 8; ++w) v += *(LAS const float*)(L + G_RED + ((w * 32 + tk) * 8 + n) * 4);
            F_gates[(size_t)(32 * st + tk) * 8 + n] = n < 4 ? v : (fminf(v, 0.f) - log1pf(__expf(-fabsf(v)))); }
    }
#undef G_LOAD
}

namespace scan {
using f32x16 = __attribute__((ext_vector_type(16))) float;
typedef float f32x2_t __attribute__((ext_vector_type(2))); typedef __bf16 bf16x2_t __attribute__((ext_vector_type(2)));
typedef short s16x4 __attribute__((ext_vector_type(4)));
#define MFMA32(a, b, c) __builtin_amdgcn_mfma_f32_32x32x16_bf16((a), (b), (c), 0, 0, 0)
__device__ __forceinline__ unsigned cvtpk(float lo, float hi) { f32x2_t v = {lo, hi}; bf16x2_t b = __builtin_convertvector(v, bf16x2_t); return __builtin_bit_cast(unsigned, b); }
template <int S> __device__ __forceinline__ bf16x8 pack_step(const f32x16& x) {
    u32x4 p = {cvtpk(x[8 * S], x[8 * S + 1]), cvtpk(x[8 * S + 2], x[8 * S + 3]), cvtpk(x[8 * S + 4], x[8 * S + 5]), cvtpk(x[8 * S + 6], x[8 * S + 7])};
    return __builtin_bit_cast(bf16x8, p);
}
__device__ __forceinline__ int crow(int reg, int hh) { return (reg & 3) + 8 * (reg >> 2) + 4 * hh; }
__device__ __forceinline__ bf16x8 ld128(LAS const unsigned char* p) { return *(LAS const bf16x8*)p; }
__device__ __forceinline__ bf16x8 ld2x64(LAS const unsigned char* p) { const s16x4 a = *(LAS const s16x4*)p, b = *(LAS const s16x4*)(p + 16); return __builtin_shufflevector(a, b, 0, 1, 2, 3, 4, 5, 6, 7); }
__device__ __forceinline__ float lo_bf(unsigned w) { return __uint_as_float(w << 16); }
__device__ __forceinline__ float hi_bf(unsigned w) { return __uint_as_float(w & 0xffff0000u); }

constexpr int HQS = 528, HTS = 80, HOS = 1040;
constexpr int H_Q = 0, H_K = H_Q + 32 * HQS, H_KT = H_K + 32 * HQS, H_VT = H_KT + 256 * HTS, H_DEC = H_VT + 256 * HTS, H_HT = H_DEC + 1024, H_NW = H_HT + 4096, H_O = H_NW + 512, H_END = H_O + 32 * HOS;
static_assert(H_END <= SCAN_LDS, "hgrn lds");
__device__ __forceinline__ void hgrn_pair_item(Ctx& F, int l, int b, int hp) {
    const int tid0 = F.tid, wave = F.wave, hw = wave >> 2, wq = wave & 3;
    LAS unsigned char* L = F.lds;
    if (tid0 < 128) ((LAS float*)(L + H_NW))[tid0] = F_hgrn_norm_w[l * 128 + tid0];
    const size_t row0 = (size_t)b * SEQ;
    const bf16_t* pbase0 = F_proj + row0 * P_IN + hp * 256 + hw * 128 + wq * 32;
    bf16_t* gbase0 = F_proj + row0 * P_IN + O_HG + hp * 256 + hw * 128;
    f32x16 S[4];
#pragma unroll
    for (int i = 0; i < 4; ++i) S[i] = f32x16{};
    unsigned rq[8], rf[8], rv[8];
#define HG_LOADRAW(cc) do { const bf16_t* pb_ = pbase0 + 2 * (tid0 & 15) + (size_t)((cc) * 32 + 8 * ((tid0 >> 4) & 3)) * P_IN; \
        _Pragma("unroll") for (int i = 0; i < 8; ++i) rf[i] = *(const unsigned*)(pb_ + (size_t)i * P_IN + O_HF); \
        _Pragma("unroll") for (int i = 0; i < 8; ++i) { rq[i] = *(const unsigned*)(pb_ + (size_t)i * P_IN + O_HQ); rv[i] = *(const unsigned*)(pb_ + (size_t)i * P_IN + O_HI); } } while (0)
    HG_LOADRAW(0);
    __syncthreads();
    u32x4 g0 = {0u, 0u, 0u, 0u}, g1 = {0u, 0u, 0u, 0u};
#pragma unroll 1
    for (int s_ = 0; s_ < 2 * (SEQ / 32) + 2; ++s_) {
        int tid = tid0; asm volatile("" : "+v"(tid));
        const int lane = tid & 63, r = lane & 31, hh = lane >> 5;
        const int cb = hw * 128;
        if (((s_ & 1) == hw)) {
            const int c = (s_ - hw) >> 1;
            const int tl = tid & 255, ot = tl >> 3, opart = tl & 7;
            bf16_t* gbase = gbase0 + (size_t)ot * P_IN + 16 * opart;
            if (c >= 1) {
                f32x4 ov[4]; float ss = 0.f;
#pragma unroll
                for (int j = 0; j < 4; ++j) { ov[j] = *(LAS const f32x4*)(L + H_O + ot * HOS + (cb + 16 * opart + 4 * j) * 4); ss += (ov[j][0] * ov[j][0] + ov[j][1] * ov[j][1]) + (ov[j][2] * ov[j][2] + ov[j][3] * ov[j][3]); }
                ss += swz_xor<1>(ss); ss += swz_xor<2>(ss); ss += swz_xor<4>(ss);
                const float rs = rsqrtf(ss * (1.0f / 128.0f) + EPS);
                unsigned gw[8] = {g0[0], g0[1], g0[2], g0[3], g1[0], g1[1], g1[2], g1[3]}; unsigned ow[8];
#pragma unroll
                for (int j = 0; j < 4; ++j) { const f32x4 nwv = *(LAS const f32x4*)(L + H_NW + (16 * opart + 4 * j) * 4);
                    const float ga = lo_bf(gw[2 * j]), gb = hi_bf(gw[2 * j]), gc = lo_bf(gw[2 * j + 1]), gd = hi_bf(gw[2 * j + 1]);
                    ow[2 * j] = cvtpk(ov[j][0] * rs * nwv[0] * ga, ov[j][1] * rs * nwv[1] * gb);
                    ow[2 * j + 1] = cvtpk(ov[j][2] * rs * nwv[2] * gc, ov[j][3] * rs * nwv[3] * gd); }
                bf16_t* gp = gbase + (size_t)((c - 1) * 32) * P_IN;
                *(u32x4*)gp = (u32x4){ow[0], ow[1], ow[2], ow[3]}; *(u32x4*)(gp + 8) = (u32x4){ow[4], ow[5], ow[6], ow[7]};
            }
            if (c < SEQ / 32) {
                g0 = *(const u32x4*)(gbase + (size_t)(c * 32) * P_IN); g1 = *(const u32x4*)(gbase + (size_t)(c * 32) * P_IN + 8);
                const int pr = lane & 15, tq = lane >> 4, c0 = cb + wq * 32 + 2 * pr;
                float cu0[8], cu1[8]; float cs0 = 0.f, cs1 = 0.f;
#pragma unroll
                for (int i = 0; i < 8; ++i) { cs0 += lo_bf(rf[i]); cu0[i] = cs0; cs1 += hi_bf(rf[i]); cu1[i] = cs1; }
                float off0 = 0.f, off1 = 0.f, bl0 = 0.f, bl1 = 0.f;
#pragma unroll
                for (int qq = 0; qq < 4; ++qq) { const float t0 = __shfl(cs0, pr + 16 * qq), t1 = __shfl(cs1, pr + 16 * qq); bl0 += t0; bl1 += t1; if (qq < tq) { off0 += t0; off1 += t1; } }
                unsigned kt0[4], kt1[4], vt0[4], vt1[4]; float rp0 = 0.f, rp1 = 0.f;
#pragma unroll
                for (int i = 0; i < 8; ++i) {
                    const float bc0 = cu0[i] + off0, bc1 = cu1[i] + off1;
                    const float e0 = __builtin_amdgcn_exp2f(bc0 - bl0), e1 = __builtin_amdgcn_exp2f(bc1 - bl1);
                    const float r0 = rcp_f(e0), r1 = rcp_f(e1);
                    const float f0 = i == 0 ? __builtin_amdgcn_exp2f(lo_bf(rf[0])) : e0 * rp0, f1 = i == 0 ? __builtin_amdgcn_exp2f(hi_bf(rf[0])) : e1 * rp1;
                    rp0 = r0; rp1 = r1;
                    const float q0 = lo_bf(rq[i]) * e0, q1 = hi_bf(rq[i]) * e1;
                    const float k0 = (1.f - f0) * r0, k1 = (1.f - f1) * r1;
                    const unsigned kb = cvtpk(k0, k1);
                    *(LAS unsigned*)(L + H_Q + (8 * tq + i) * HQS + c0 * 2) = cvtpk(q0, q1);
                    *(LAS unsigned*)(L + H_K + (8 * tq + i) * HQS + c0 * 2) = kb;
                    if (i & 1) { kt0[i >> 1] |= kb << 16; kt1[i >> 1] |= kb & 0xffff0000u; vt0[i >> 1] |= rv[i] << 16; vt1[i >> 1] |= rv[i] & 0xffff0000u; }
                    else { kt0[i >> 1] = kb & 0xffffu; kt1[i >> 1] = kb >> 16; vt0[i >> 1] = rv[i] & 0xffffu; vt1[i >> 1] = rv[i] >> 16; }
                }
                *(LAS u32x4*)(L + H_KT + c0 * HTS + 16 * tq) = (u32x4){kt0[0], kt0[1], kt0[2], kt0[3]};
                *(LAS u32x4*)(L + H_KT + (c0 + 1) * HTS + 16 * tq) = (u32x4){kt1[0], kt1[1], kt1[2], kt1[3]};
                *(LAS u32x4*)(L + H_VT + c0 * HTS + 16 * tq) = (u32x4){vt0[0], vt0[1], vt0[2], vt0[3]};
                *(LAS u32x4*)(L + H_VT + (c0 + 1) * HTS + 16 * tq) = (u32x4){vt1[0], vt1[1], vt1[2], vt1[3]};
                if (tq == 0) *(LAS f32x2_t*)(L + H_DEC + c0 * 4) = (f32x2_t){__builtin_amdgcn_exp2f(bl0), __builtin_amdgcn_exp2f(bl1)};
            }
        } else {
            const int c = (s_ - 1 - hw) >> 1;
            if (s_ >= 1 + hw && c < SEQ / 32) {
                if (c + 1 < SEQ / 32) HG_LOADRAW(c + 1);
                const int vs = wq;
#pragma unroll
                for (int db = 0; db < 4; ++db)
#pragma unroll
                    for (int g = 0; g < 4; ++g) { const f32x4 dv = *(LAS const f32x4*)(L + H_DEC + (cb + 32 * db + 8 * g + 4 * hh) * 4);
#pragma unroll
                        for (int i = 0; i < 4; ++i) S[db][4 * g + i] *= dv[i]; }
#define SB() __builtin_amdgcn_sched_barrier(0)
                LAS const unsigned char* qrow = L + H_Q + r * HQS + cb * 2;
                LAS const unsigned char* krow = L + H_K + r * HQS + cb * 2;
                LAS const unsigned char* vrow = L + H_VT + (cb + 32 * vs + r) * HTS;
                bf16x8 pa0, pa1;
                { f32x16 x1 = f32x16{};
                  bf16x8 fa0 = ld128(krow + (8 * hh) * 2), fb0 = ld128(qrow + (8 * hh) * 2), fa1 = ld128(krow + (16 + 8 * hh) * 2), fb1 = ld128(qrow + (16 + 8 * hh) * 2); SB();
#pragma unroll
                  for (int ks = 0; ks < 8; ks += 2) {
                      x1 = MFMA32(fa0, fb0, x1); if (ks + 2 < 8) { fa0 = ld128(krow + (16 * (ks + 2) + 8 * hh) * 2); fb0 = ld128(qrow + (16 * (ks + 2) + 8 * hh) * 2); } SB();
                      x1 = MFMA32(fa1, fb1, x1); if (ks + 3 < 8) { fa1 = ld128(krow + (16 * (ks + 3) + 8 * hh) * 2); fb1 = ld128(qrow + (16 * (ks + 3) + 8 * hh) * 2); } SB();
                  }
#pragma unroll
                  for (int i = 0; i < 16; ++i) x1[i] = (crow(i, hh) <= r) ? x1[i] : 0.f;
                  pa0 = pack_step<0>(x1); pa1 = pack_step<1>(x1); }
                f32x16 o = f32x16{};
                { bf16x8 v0 = ld2x64(vrow + (4 * hh) * 2), v1 = ld2x64(vrow + (16 + 4 * hh) * 2);
                  bf16x8 q0 = ld2x64(qrow + (4 * hh) * 2), q1 = ld2x64(qrow + (16 + 4 * hh) * 2); SB();
                  o = MFMA32(pa0, v0, o); SB();
                  o = MFMA32(pa1, v1, o); SB();
#pragma unroll
                  for (int db = 0; db < 4; ++db) {
                      o = MFMA32(q0, pack_step<0>(S[db]), o); if (db + 1 < 4) q0 = ld2x64(qrow + (32 * (db + 1) + 4 * hh) * 2); SB();
                      o = MFMA32(q1, pack_step<1>(S[db]), o); if (db + 1 < 4) q1 = ld2x64(qrow + (32 * (db + 1) + 16 + 4 * hh) * 2); SB();
                  } }
                { const bf16x8 vb0 = ld128(vrow + (8 * hh) * 2), vb1 = ld128(vrow + (16 + 8 * hh) * 2);
                  LAS const unsigned char* ktr = L + H_KT + (cb + r) * HTS;
                  bf16x8 k0 = ld128(ktr + (8 * hh) * 2), k1 = ld128(ktr + (16 + 8 * hh) * 2); SB();
#pragma unroll
                  for (int db = 0; db < 4; ++db) {
                      S[db] = MFMA32(k0, vb0, S[db]); if (db + 1 < 4) k0 = ld128(ktr + 32 * (db + 1) * HTS + (8 * hh) * 2); SB();
                      S[db] = MFMA32(k1, vb1, S[db]); if (db + 1 < 4) k1 = ld128(ktr + 32 * (db + 1) * HTS + (16 + 8 * hh) * 2); SB();
                  } }
#undef SB
#pragma unroll
                for (int i = 0; i < 16; ++i) *(LAS float*)(L + H_O + crow(i, hh) * HOS + (cb + 32 * vs + r) * 4) = o[i];
            }
        }
        __syncthreads();
    }
#undef HG_LOADRAW
}

constexpr int MQS = 400, MVS = 448, MHS = 912, MRS = 384;
constexpr int M_Q = 0, M_K = M_Q + 32 * MQS, M_V = M_K + 32 * MQS, M_H = M_V + 32 * MVS, M_W = M_H + 32 * MHS,
              M_WK = M_W, M_WV = M_WK + 768 * 4, M_NW = M_WV + 768 * 4, M_SK = M_NW + 768, M_SC = M_SK + 768, M_RAW = M_SC + 1024 + 256, M_PA = M_RAW + 2 * 2 * 32 * MRS, M_END = M_PA + 2048 + 16;
static_assert(M_END <= SCAN_LDS, "mlstm lds");
typedef short v4i16_t __attribute__((ext_vector_type(4)));
__device__ __forceinline__ s16x4 trd(LAS const unsigned char* p) { return __builtin_bit_cast(s16x4, __builtin_amdgcn_ds_read_tr16_b64_v4i16((LAS v4i16_t*)p)); }
__device__ __forceinline__ bf16x8 trd2(LAS const unsigned char* p, int rowstep4) { const s16x4 a = trd(p), b = trd(p + rowstep4); return __builtin_shufflevector(a, b, 0, 1, 2, 3, 4, 5, 6, 7); }
__device__ __forceinline__ void mlstm_item(Ctx& F, int l, int b, int h) {
    const int tid0 = F.tid, wave = F.wave;
    LAS unsigned char* L = F.lds;
    const size_t row0 = (size_t)b * SEQ;
    { const int tid = tid0;
#pragma unroll 1
    for (int i = tid; i < 768; i += 512) { const int g_ = i >> 4, ii_ = (i >> 2) & 3, o_ = i & 3, dst = (ii_ * 48 + g_) * 4 + o_;
        const float* wk_ = F_wk + (l * 192 + h * 48 + g_) * 16 + ii_ * 4; const float* wq_ = F_wq + (l * 192 + h * 48 + g_) * 16 + o_ * 4;
        ((LAS float*)(L + M_WK))[dst] = (wk_[0] * wq_[0] + wk_[1] * wq_[1]) + (wk_[2] * wq_[2] + wk_[3] * wq_[3]);
        ((LAS float*)(L + M_WV))[dst] = F_wv[(l * 192 + h * 48) * 16 + i]; }
    if (tid < 192) { ((LAS float*)(L + M_NW))[tid] = F_ml_norm_w[l * 768 + h * 192 + tid]; ((LAS float*)(L + M_SK))[tid] = F_ml_skip[l * 768 + h * 192 + tid]; }
    if (tid == 0) *(LAS int*)(L + M_PA + 2048) = 0;
    { const int row = tid >> 4, cw_ = tid & 15; ((LAS unsigned*)(L + M_V + row * MVS + 384))[cw_] = cw_ == 0 ? 0x00003f80u : 0u; }
    }
    bf16_t* zbase0 = F_proj + row0 * P_IN + O_MZ + h * 192;
    float Bprev = 0.f, Mprev = -1e30f; float gi = 0.f, gf = 0.f;
    const float* gatep0 = F_gates + row0 * 8 + h;
    f32x16 C[6];
#pragma unroll
    for (int i = 0; i < 6; ++i) C[i] = f32x16{};
    u32x4 xr[3];
    const bf16_t* xhead = F_proj + row0 * P_IN + O_MX + h * 192; const bf16_t* chead = F_xcb + row0 * 768 + h * 192;
#define ML_LOADRAW(cc) do { _Pragma("unroll") for (int k = 0; k < 3; ++k) { const int p_ = tid0 + 512 * k; const int q_ = p_ % 768, rw_ = q_ / 24, cl_ = q_ % 24; const size_t tg = (size_t)(cc) * 32 + rw_; \
        xr[k] = p_ < 768 ? *(const u32x4*)(chead + tg * 768 + 8 * cl_) : *(const u32x4*)(xhead + tg * P_IN + 8 * cl_); } } while (0)
#define ML_STORERAW(cc) do { _Pragma("unroll") for (int k = 0; k < 3; ++k) { const int p_ = tid0 + 512 * k; *(LAS u32x4*)(L + M_RAW + ((cc) & 1) * 2 * 32 * MRS + p_ * 16) = xr[k]; } } while (0)
#define ML_LOADG(cc) do { const float* gp_ = gatep0 + (size_t)(tid0 & 31) * 8; gi = gp_[(size_t)(cc) * 32 * 8]; gf = gp_[(size_t)(cc) * 32 * 8 + 4]; } while (0)
#define ML_SCALARS(cc) do { const int r = tid0 & 31, hh = (tid0 >> 5) & 1, lane = tid0 & 63; LAS float* sc_ = (LAS float*)(L + M_SC) + ((cc) & 1) * 128; LAS float* tmp_ = (LAS float*)(L + M_SC) + 256; \
        if (hh == 0) { tmp_[r] = gf; tmp_[32 + r] = gi; } \
        float Bt_ = Bprev, Bl_ = Bprev, mx_ = -3.0e38f; \
        _Pragma("unroll 4") for (int s_ = 0; s_ < 32; ++s_) { const float lf_ = tmp_[s_], ip_ = tmp_[32 + s_]; Bl_ += lf_; if (s_ <= r) Bt_ = Bl_; mx_ = fmaxf(mx_, ip_ - Bl_); } \
        const float ML_ = fmaxf(Mprev, mx_), a_ = gi - Bt_; \
        if (hh == 0) { sc_[r] = __expf(a_ - ML_); sc_[32 + r] = __expf(-Bt_ - ML_); } if (lane == 0) sc_[64] = __expf(Mprev - ML_); \
        Bprev = Bl_; Mprev = ML_; } while (0)
    ML_LOADRAW(0); ML_STORERAW(0); ML_LOADRAW(1);
    if (wave == 7) { ML_LOADG(0); ML_SCALARS(0); ML_LOADG(1); }
    __syncthreads();
    for (int c = 0; c < SEQ / 32; ++c) {
        int tid = tid0; asm volatile("" : "+v"(tid));
        const int lane = tid & 63, r = lane & 31, hh = lane >> 5, g = tid % 48, tsl = tid / 48, ot = tid >> 4, opart = tid & 15;
        bf16_t* zbase = zbase0 + (size_t)ot * P_IN + 12 * opart;
        u32x2 zr[3];
#pragma unroll
        for (int j = 0; j < 3; ++j) zr[j] = *(const u32x2*)(zbase + (size_t)(c * 32) * P_IN + 4 * j);
        if (tid < 384) {
            LAS const float* sc = (LAS const float*)(L + M_SC) + (c & 1) * 128;
            f32x4 wk[4], wv[4];
#pragma unroll
            for (int i = 0; i < 4; ++i) { wk[i] = *(LAS const f32x4*)(L + M_WK + (i * 48 + g) * 16); wv[i] = *(LAS const f32x4*)(L + M_WV + (i * 48 + g) * 16); }
#pragma unroll
            for (int a = 0; a < 4; ++a) {
                const int t = 4 * tsl + a;
                LAS const unsigned char* raw = L + M_RAW + (c & 1) * 2 * 32 * MRS + t * MRS + 8 * g;
                const u32x2 xcw = *(LAS const u32x2*)raw, mxw = *(LAS const u32x2*)(raw + 32 * MRS);
                const float xcv[4] = {lo_bf(xcw[0]), hi_bf(xcw[0]), lo_bf(xcw[1]), hi_bf(xcw[1])}, xl[4] = {lo_bf(mxw[0]), hi_bf(mxw[0]), lo_bf(mxw[1]), hi_bf(mxw[1])};
                float kt[4], vv[4];
#pragma unroll
                for (int i = 0; i < 4; ++i)
#pragma unroll
                    for (int o = 0; o < 4; ++o) { if (i == 0) { kt[o] = xcv[0] * wk[0][o]; vv[o] = xl[0] * wv[0][o]; } else { kt[o] += xcv[i] * wk[i][o]; vv[o] += xl[i] * wv[i][o]; } }
                const float kw = 0.07216878364870323f * sc[t];
#pragma unroll
                for (int o = 0; o < 4; ++o) kt[o] *= kw;
                *(LAS u32x2*)(L + M_Q + t * MQS + 8 * g) = xcw;
                *(LAS u32x2*)(L + M_K + t * MQS + 8 * g) = (u32x2){cvtpk(kt[0], kt[1]), cvtpk(kt[2], kt[3])};
                *(LAS u32x2*)(L + M_V + t * MVS + 8 * g) = (u32x2){cvtpk(vv[0], vv[1]), cvtpk(vv[2], vv[3])};
            }
        }
        __syncthreads();
#define SB() __builtin_amdgcn_sched_barrier(0)
        if (wave < 7) {
            const float decc = ((LAS const float*)(L + M_SC))[(c & 1) * 128 + 64];
#pragma unroll
            for (int db = 0; db < 6; ++db) C[db] *= decc;
            LAS const unsigned char* qrow = L + M_Q + r * MQS;
            const int i16 = lane & 15, tq_ = i16 >> 2, tp_ = i16 & 3, g1_ = (lane >> 4) & 1;
            LAS const unsigned char* vtr = L + M_V + tq_ * MVS + (32 * wave + 16 * g1_ + 4 * tp_) * 2;
            LAS const unsigned char* ktr = L + M_K + tq_ * MQS + (16 * g1_ + 4 * tp_) * 2;
            f32x16 X = f32x16{};
            {
                bf16x8 q0 = ld2x64(qrow + (4 * hh) * 2), q1 = ld2x64(qrow + (16 + 4 * hh) * 2); SB();
#pragma unroll
                for (int db = 0; db < 6; ++db) {
                    X = MFMA32(q0, pack_step<0>(C[db]), X); if (db + 1 < 6) q0 = ld2x64(qrow + (32 * (db + 1) + 4 * hh) * 2); SB();
                    X = MFMA32(q1, pack_step<1>(C[db]), X); if (db + 1 < 6) q1 = ld2x64(qrow + (32 * (db + 1) + 16 + 4 * hh) * 2); SB();
                }
            }
            {
                const bf16x8 vb0 = trd2(vtr + (8 * hh) * MVS, 4 * MVS), vb1 = trd2(vtr + (16 + 8 * hh) * MVS, 4 * MVS);
                bf16x8 k0 = trd2(ktr + (8 * hh) * MQS, 4 * MQS), k1 = trd2(ktr + (16 + 8 * hh) * MQS, 4 * MQS); SB();
#pragma unroll
                for (int db = 0; db < 6; ++db) {
                    C[db] = MFMA32(k0, vb0, C[db]); if (db + 1 < 6) k0 = trd2(ktr + (8 * hh) * MQS + 64 * (db + 1), 4 * MQS); SB();
                    C[db] = MFMA32(k1, vb1, C[db]); if (db + 1 < 6) k1 = trd2(ktr + (16 + 8 * hh) * MQS + 64 * (db + 1), 4 * MQS); SB();
                }
            }
            {
                const bf16x8 v0 = trd2(vtr + (4 * hh) * MVS, 8 * MVS), v1 = trd2(vtr + (16 + 4 * hh) * MVS, 8 * MVS);
                while (*(volatile LAS int*)(L + M_PA + 2048) != c + 1) __builtin_amdgcn_s_sleep(1);
                asm volatile("" ::: "memory");
                const bf16x8 pa0 = *(LAS const bf16x8*)(L + M_PA + lane * 16), pa1 = *(LAS const bf16x8*)(L + M_PA + 1024 + lane * 16); SB();
                X = MFMA32(pa0, v0, X);
                X = MFMA32(pa1, v1, X);
            }
#pragma unroll
            for (int i = 0; i < 16; ++i) *(LAS float*)(L + M_H + crow(i, hh) * MHS + (32 * wave + r) * 4) = X[i];
        } else {
            LAS const unsigned char* qrow = L + M_Q + r * MQS;
            LAS const unsigned char* krow = L + M_K + r * MQS;
            f32x16 x1 = f32x16{};
            bf16x8 fa0 = ld128(krow + (8 * hh) * 2), fb0 = ld128(qrow + (8 * hh) * 2), fa1 = ld128(krow + (16 + 8 * hh) * 2), fb1 = ld128(qrow + (16 + 8 * hh) * 2); SB();
#pragma unroll
            for (int ks = 0; ks < 12; ks += 2) {
                x1 = MFMA32(fa0, fb0, x1); if (ks + 2 < 12) { fa0 = ld128(krow + (16 * (ks + 2) + 8 * hh) * 2); fb0 = ld128(qrow + (16 * (ks + 2) + 8 * hh) * 2); } SB();
                x1 = MFMA32(fa1, fb1, x1); if (ks + 3 < 12) { fa1 = ld128(krow + (16 * (ks + 3) + 8 * hh) * 2); fb1 = ld128(qrow + (16 * (ks + 3) + 8 * hh) * 2); } SB();
            }
#pragma unroll
            for (int i = 0; i < 16; ++i) x1[i] = (crow(i, hh) <= r) ? x1[i] : 0.f;
            *(LAS bf16x8*)(L + M_PA + lane * 16) = pack_step<0>(x1); *(LAS bf16x8*)(L + M_PA + 1024 + lane * 16) = pack_step<1>(x1);
            asm volatile("s_waitcnt lgkmcnt(0)" ::: "memory");
            if (lane == 0) *(volatile LAS int*)(L + M_PA + 2048) = c + 1;
            if (c + 1 < SEQ / 32) { ML_SCALARS(c + 1); if (c + 2 < SEQ / 32) ML_LOADG(c + 2); }
        }
#undef SB
        if (c + 1 < SEQ / 32) { ML_STORERAW(c + 1); if (c + 2 < SEQ / 32) ML_LOADRAW(c + 2); }
        __syncthreads();
        {
            const float Y = *(LAS const float*)(L + M_H + ot * MHS + 192 * 4), eb = ((LAS const float*)(L + M_SC))[(c & 1) * 128 + 32 + ot];
            const float idn = rcp_f(fmaxf(fabsf(Y), eb));
            float hv[12]; float s1 = 0.f;
#pragma unroll
            for (int j = 0; j < 3; ++j) { const f32x4 v = *(LAS const f32x4*)(L + M_H + ot * MHS + (12 * opart + 4 * j) * 4);
#pragma unroll
                for (int i = 0; i < 4; ++i) { hv[4 * j + i] = v[i] * idn; s1 += hv[4 * j + i]; } }
            s1 += swz_xor<1>(s1); s1 += swz_xor<2>(s1); s1 += swz_xor<4>(s1); s1 += swz_xor<8>(s1);
            const float mean = s1 * (1.0f / 192.0f); float s2 = 0.f;
#pragma unroll
            for (int i = 0; i < 12; ++i) { hv[i] -= mean; s2 += hv[i] * hv[i]; }
            s2 += swz_xor<1>(s2); s2 += swz_xor<2>(s2); s2 += swz_xor<4>(s2); s2 += swz_xor<8>(s2);
            const float rs = rsqrtf(s2 * (1.0f / 192.0f) + EPS);
            u32x2 ow[3];
#pragma unroll
            for (int j = 0; j < 3; ++j) { const f32x4 nwv = *(LAS const f32x4*)(L + M_NW + (12 * opart + 4 * j) * 4), skv = *(LAS const f32x4*)(L + M_SK + (12 * opart + 4 * j) * 4);
                const u32x2 xw = *(LAS const u32x2*)(L + M_RAW + (c & 1) * 2 * 32 * MRS + ot * MRS + (12 * opart + 4 * j) * 2);
                const float x0 = lo_bf(xw[0]), x1v = hi_bf(xw[0]), x2 = lo_bf(xw[1]), x3 = hi_bf(xw[1]);
                const float z0 = lo_bf(zr[j][0]), z1 = hi_bf(zr[j][0]), z2 = lo_bf(zr[j][1]), z3 = hi_bf(zr[j][1]);
                ow[j][0] = cvtpk((hv[4 * j] * rs * nwv[0] + skv[0] * x0) * z0, (hv[4 * j + 1] * rs * nwv[1] + skv[1] * x1v) * z1);
                ow[j][1] = cvtpk((hv[4 * j + 2] * rs * nwv[2] + skv[2] * x2) * z2, (hv[4 * j + 3] * rs * nwv[3] + skv[3] * x3) * z3); }
            bf16_t* zp = zbase + (size_t)(c * 32) * P_IN;
#pragma unroll
            for (int j = 0; j < 3; ++j) *(u32x2*)(zp + 4 * j) = ow[j];
        }
    }
#undef ML_LOADRAW
#undef ML_STORERAW
#undef ML_LOADG
#undef ML_SCALARS
}
#undef MFMA32
}

__device__ __forceinline__ void phase_mixers(Ctx& F, int l) {
    constexpr int N_ML = BATCH * 4, N_HG = BATCH * 3, N_XA = BATCH * 4 * (SEQ / 256);
    volatile LAS int* nxt = (volatile LAS int*)(F.lds + MISC_OFF);
    {
        unsigned* ctr = F_ctl + CW_QUEUE + 256 * l;
        for (;;) {
            __syncthreads();
            if (F.tid == 0) *nxt = (int)atomicAdd(ctr, 1u);
            __syncthreads();
            const int it = __builtin_amdgcn_readfirstlane(*nxt);
            if (it >= N_ML) break;
            scan::mlstm_item(F, l, it >> 2, it & 3);
        }
    }
    {
        unsigned* ctr = F_ctl + CW_QUEUE + 256 * l + 64;
        for (;;) {
            __syncthreads();
            if (F.tid == 0) *nxt = (int)atomicAdd(ctr, 1u);
            __syncthreads();
            const int it = __builtin_amdgcn_readfirstlane(*nxt);
            if (it >= N_HG) break;
            scan::hgrn_pair_item(F, l, it / 3, it % 3);
        }
    }
    {
        unsigned* ctr = F_ctl + CW_QUEUE + 256 * l + 128;
        for (;;) {
            __syncthreads();
            if (F.tid == 0) *nxt = (int)atomicAdd(ctr, 1u);
            __syncthreads();
            const int u = __builtin_amdgcn_readfirstlane(*nxt);
            if (u >= N_XA) break;
            const int qp = u & 7, h = (u >> 3) & 3, b = u >> 5;
            const size_t qrow = (size_t)b * SEQ + qp * 256;
            const bf16_t* Kh = F_mkv + (size_t)(b * MEM_LEN) * 2048 + l * 1024 + h * 128;
            xattn::attn_unit<1>((const xattn::bf16*)(F_proj + qrow * P_IN + O_AQ + h * 128), (const xattn::bf16*)Kh, (const xattn::bf16*)(Kh + 512),
                                F_proj + qrow * P_IN + O_AZ + h * 128, F_xa_norm_w + l * 128, (char*)(unsigned char*)F.lds);
        }
    }
}

__device__ __forceinline__ void phase_final(Ctx& F) {
    const int gw = blockIdx.x * 8 + F.wave, NGW = F.G * 8;
    for (int rb = gw * 4; rb < M_TOK; rb += NGW * 4) {
        u32x2 v[4][4];
#pragma unroll
        for (int q = 0; q < 4; ++q)
#pragma unroll
            for (int j = 0; j < 4; ++j) v[q][j] = ((const u32x2*)(F_xb + (size_t)(rb + q) * D_MODEL) + F.lane)[64 * j];
#pragma unroll
        for (int q = 0; q < 4; ++q) { const float rs = rsqrtf(F_ss2[rb + q] * (1.0f / 1024.0f) + EPS);
            f32x4* p = (f32x4*)(F.out + (size_t)(rb + q) * D_MODEL) + F.lane; const f32x4* w = (const f32x4*)F_final_w + F.lane;
#pragma unroll
            for (int j = 0; j < 4; ++j) { const f32x4 x = {__uint_as_float(v[q][j].x << 16), __uint_as_float(v[q][j].x & 0xffff0000u), __uint_as_float(v[q][j].y << 16), __uint_as_float(v[q][j].y & 0xffff0000u)};
                p[64 * j] = x * rs * w[64 * j]; } }
    }
}

constexpr int N_PHASES = 10;
__global__ void __launch_bounds__(512, 2) fwd_kernel(Params P) {
    extern __shared__ __attribute__((aligned(16))) unsigned char lds_raw[];
    Ctx F;
    F.lds = (LAS unsigned char*)lds_raw; F.tid = threadIdx.x; F.lane = F.tid & 63; F.wave = __builtin_amdgcn_readfirstlane(F.tid >> 6); F.G = gridDim.x;
    F.inp = P.in; F.out = P.out; F.ws = P.ws;
    const int lo = P.ph_lo, hi = P.ph_hi;
#define IN(k) (lo <= (k) && (k) < hi)
#if MK_SINGLE
    volatile LAS unsigned* bar_st = (volatile LAS unsigned*)(F.lds + MISC_OFF + 64);
    if (threadIdx.x < 2) bar_st[threadIdx.x] = 0u;
    __syncthreads();
    const XcdBarrier gbar = xcd_barrier_post(F_ctl + CW_BAR, bar_st);
#define SEAM(k) do { if (IN(k) && IN((k) + 1)) { xcd_barrier(gbar); } } while (0)
#else
#define SEAM(k) do { } while (0)
#endif
    if (IN(0)) { phase_prep(F); }
    SEAM(0);
    if (IN(1)) {
        { pg8::Gemm g{F_memb, F_WkvT, M_MEM, 2048, D_MODEL, D_MODEL}; pg8::StaticOrder S; S.init(M_MEM, 2048, F.G, (int)blockIdx.x);
          pg8::EpiScaleBf16 E{F_mkv, 2048, F_ssm};
          pg8::gemm_phase<pg8::EpiScaleBf16, pg8::StaticOrder, true, true>(F.lds, g, S, E); }
        { pg8::Gemm g{F_xb, F_WinT, M_TOK, P_IN, D_MODEL, D_MODEL}; pg8::StaticOrder S; S.init(M_TOK, P_IN, F.G, (int)blockIdx.x);
          pg8::EpiProj E{F_proj, F_ss0, F_lb};
          pg8::gemm_phase<pg8::EpiProj, pg8::StaticOrder, true, true>(F.lds, g, S, E); }
    }
    SEAM(1);
    if (IN(2)) phase_gates(F, 0);
    SEAM(2);
    if (IN(3)) phase_mixers(F, 0);
    SEAM(3);
    if (IN(4)) { pg8::Gemm g{F_proj, F_WoutT, M_TOK, D_MODEL, D_MIX, P_IN}; pg8::StaticOrder S; S.init(M_TOK, D_MODEL, F.G, (int)blockIdx.x);
        pg8::EpiResid<true> E{F_x, F.out, F_xb, F_ss1};
        pg8::gemm_phase<pg8::EpiResid<true>, pg8::StaticOrder, true, true>(F.lds, g, S, E); }
    SEAM(4);
    if (IN(5)) { pg8::Gemm g{F_xb, F_WinT + (size_t)P_IN * D_MODEL, M_TOK, P_IN, D_MODEL, D_MODEL}; pg8::StaticOrder S; S.init(M_TOK, P_IN, F.G, (int)blockIdx.x);
        pg8::EpiProj E{F_proj, F_ss1, F_lb + 768};
        pg8::gemm_phase<pg8::EpiProj, pg8::StaticOrder, true, true>(F.lds, g, S, E); }
    SEAM(5);
    if (IN(6)) phase_gates(F, 1);
    SEAM(6);
    if (IN(7)) phase_mixers(F, 1);
    SEAM(7);
    if (IN(8)) { pg8::Gemm g{F_proj, F_WoutT + (size_t)D_MODEL * D_MIX, M_TOK, D_MODEL, D_MIX, P_IN}; pg8::StaticOrder S; S.init(M_TOK, D_MODEL, F.G, (int)blockIdx.x);
        pg8::EpiResid<false> E{F.out, F.out, F_xb, F_ss2};
        pg8::gemm_phase<pg8::EpiResid<false>, pg8::StaticOrder, true, true>(F.lds, g, S, E); }
    SEAM(8);
    if (IN(9)) phase_final(F);
#undef IN
#undef SEAM
}

extern "C" void kernel_launch(void* const* d_in, const int* in_sizes, int n_in, void* d_out, int out_size, void* d_ws, size_t ws_size, hipStream_t stream) {
    static int grid = 0;
    if (grid == 0) {
        if (n_in != 20 || in_sizes[0] != M_TOK * D_MODEL || out_size != M_TOK * D_MODEL || ws_size < WS_END) {
            fprintf(stderr, "kernel_launch: unexpected shapes: n_in %d in0 %d out %d ws %zu (need >= %zu)\n", n_in, n_in > 0 ? in_sizes[0] : -1, out_size, ws_size, (size_t)WS_END); grid = -1; return; }
        int dev = 0, cus = 0, per_cu = 0;
        if (hipGetDevice(&dev) != hipSuccess || hipDeviceGetAttribute(&cus, hipDeviceAttributeMultiprocessorCount, dev) != hipSuccess) { fprintf(stderr, "kernel_launch: device query failed\n"); grid = -1; return; }
        if (hipFuncSetAttribute((const void*)fwd_kernel, hipFuncAttributeMaxDynamicSharedMemorySize, LDS_BYTES) != hipSuccess) { fprintf(stderr, "kernel_launch: hipFuncSetAttribute failed\n"); grid = -1; return; }
        if (hipOccupancyMaxActiveBlocksPerMultiprocessor(&per_cu, (const void*)fwd_kernel, 512, LDS_BYTES) != hipSuccess || per_cu < 1) { fprintf(stderr, "kernel_launch: occupancy query says %d\n", per_cu); per_cu = 1; }
        (void)hipGetLastError();
        grid = cus;
        fprintf(stderr, "kernel_launch: grid %d (cus %d, occupancy %d/CU)\n", grid, cus, per_cu);
    }
    if (grid < 0) return;
    hipMemsetAsync((char*)d_ws + WS_CTL, 0, CTL_ZERO_BYTES, stream);
    Params p{};
    for (int i = 0; i < 20; ++i) p.in[i] = (const float*)d_in[i];
    p.out = (float*)d_out; p.ws = (unsigned char*)d_ws;
#if MK_SINGLE
    p.ph_lo = 0; p.ph_hi = N_PHASES;
    hipLaunchKernelGGL(fwd_kernel, dim3(grid), dim3(512), LDS_BYTES, stream, p);
    { const hipError_t le = hipPeekAtLastError(); if (le != hipSuccess) fprintf(stderr, "kernel_launch: launch failed: %s\n", hipGetErrorName(le)); }
#else
    for (int ph = 0; ph < N_PHASES; ++ph) {
        p.ph_lo = ph; p.ph_hi = ph + 1;
        hipLaunchKernelGGL(fwd_kernel, dim3(grid), dim3(512), LDS_BYTES, stream, p);
    }
    const hipError_t le = hipPeekAtLastError();
    if (le != hipSuccess) fprintf(stderr, "kernel_launch: launch failed: %s\n", hipGetErrorName(le));
#endif
}
```

```cpp
#include <hip/hip_runtime.h>
#include <hip/hip_cooperative_groups.h>
#include <hip/hip_bf16.h>
#include <cstdio>
#include <cstdint>
namespace cg = cooperative_groups;

#ifndef MK_SINGLE
#define MK_SINGLE 1
#endif

#define LAS __attribute__((address_space(3)))
typedef unsigned short bf16_t;
typedef short bf16x8 __attribute__((ext_vector_type(8)));
typedef float f32x4 __attribute__((ext_vector_type(4)));
typedef unsigned u32x4 __attribute__((ext_vector_type(4)));
typedef unsigned u32x2 __attribute__((ext_vector_type(2)));

constexpr int D_MODEL = 1024, BATCH = 32, SEQ = 2048, DEPTH = 2, MEM_LEN = 256, D_MIX = 2048;
constexpr int M_TOK = BATCH * SEQ;
constexpr int M_MEM = BATCH * MEM_LEN;
constexpr int P_IN = 5632;
constexpr float EPS = 1e-6f;
constexpr int O_HG = 0, O_MZ = 768, O_AZ = 1536, O_HQ = 2048, O_HF = 2816, O_HI = 3584, O_MX = 4352, O_AQ = 5120;
__host__ __device__ __forceinline__ int src_col(int n) {
    if (n < 768) return 2304 + n;
    if (n < 1536) return 3840 + (n - 768);
    if (n < 2048) return 5120 + (n - 1536);
    if (n < 2816) return n - 2048;
    if (n < 3584) return 768 + (n - 2816);
    if (n < 4352) return 1536 + (n - 3584);
    if (n < 5120) return 3072 + (n - 4352);
    return 4608 + (n - 5120);
}

constexpr size_t MiB = 1u << 20;
constexpr size_t WS_CTL = 0, CTL_ZERO_BYTES = 64 * 1024;
constexpr size_t WS_WIN = 2 * MiB;
constexpr size_t WS_WKV = 24 * MiB;
constexpr size_t WS_WOUT = 28 * MiB;
constexpr size_t WS_SS0 = 36 * MiB;
constexpr size_t WS_SS1 = WS_SS0 + 256 * 1024;
constexpr size_t WS_SS2 = WS_SS1 + 256 * 1024;
constexpr size_t WS_SSM = WS_SS2 + 256 * 1024;
constexpr size_t WS_LB = WS_SSM + 64 * 1024;
constexpr size_t WS_G12 = WS_LB + 8 * 1024;
constexpr size_t WS_GATES = 38 * MiB;
constexpr size_t WS_MEMB = 40 * MiB;
constexpr size_t WS_MKV = 56 * MiB;
constexpr size_t WS_XB = 88 * MiB;
constexpr size_t WS_PROJ = 216 * MiB;
constexpr size_t WS_XC = 920 * MiB;
constexpr size_t WS_END = 1016 * MiB;
constexpr int CW_BAR = 4096;
constexpr int CW_GBAR = 8192;
constexpr int CW_XCC = 9216;
constexpr int CW_QUEUE = 1024;

constexpr int RING_BYTES = 131072;
constexpr int LDS_BYTES = 163840;
constexpr int MISC_OFF = LDS_BYTES - 256;
constexpr int SCAN_LDS = MISC_OFF;

__device__ __forceinline__ float bf2f(bf16_t v) { return __uint_as_float((unsigned)v << 16); }
__device__ __forceinline__ unsigned pk2(float lo, float hi) { unsigned r; asm("v_cvt_pk_bf16_f32 %0, %1, %2" : "=v"(r) : "v"(lo), "v"(hi)); return r; }
__device__ __forceinline__ unsigned f2bf(float f) { return pk2(f, f) & 0xffffu; }
__device__ __forceinline__ float rcp_f(float x) { return __builtin_amdgcn_rcpf(x); }
typedef __bf16 bf2_t __attribute__((ext_vector_type(2)));
__device__ __forceinline__ float dot2bf(unsigned a, unsigned b, float c) { return __builtin_amdgcn_fdot2_f32_bf16(__builtin_bit_cast(bf2_t, a), __builtin_bit_cast(bf2_t, b), c, false); }
__device__ __forceinline__ float silu_f(float x) { return x * rcp_f(1.f + __expf(-x)); }
__device__ __forceinline__ float wave_sum(float v) {
#pragma unroll
    for (int o = 1; o < 64; o <<= 1) v += __shfl_xor(v, o);
    return v;
}

template <int K> __device__ __forceinline__ float swz_xor(float v) { return __builtin_bit_cast(float, __builtin_amdgcn_ds_swizzle(__builtin_bit_cast(int, v), 0x1f | (K << 10))); }

namespace pg8 {
constexpr int BM = 256, BK = 64, HALF = 128, HTB = HALF * BK * 2, STAGE_BYTES = 8 * HTB, NXCD = 8, WGM = 8;
__host__ __device__ __forceinline__ int lds_byte(int r, int c) { const int st = (r >> 4) * 2 + (c >> 5), rr = r & 15, cc = c & 31, ob = rr * 64 + cc * 2; return st * 1024 + (ob ^ (((ob >> 9) & 1) << 5)); }
__host__ __device__ __forceinline__ void stage_rc(int b, int& R, int& C) { const int st = b / 1024, sb = b % 1024, swz = sb ^ (((sb >> 9) & 1) << 5); R = (st >> 1) * 16 + swz / 64; C = (st & 1) * 32 + (swz % 64) / 2; }
__host__ __device__ __forceinline__ int perm32(int rho) { const int n = rho >> 4, i = rho & 15; return 8 * (i >> 2) + 4 * n + (i & 3); }

struct Unit { int pm, pn; };
struct Gemm { const bf16_t* A; const bf16_t* Bt; int M, N, K, lda; };

struct GroupRowsOrder {
    int nM, nN, nwg, G, c, ngrp;
    __host__ __device__ void init(int M, int N, int G_, int c_, int ngrp_) { nM = M / BM; nN = N / BM; nwg = nM * nN; G = G_; c = c_; ngrp = ngrp_; }
    __host__ __device__ bool next(int i, Unit& u) const {
        const long L = (long)i * G + c; if (L >= nwg) return false;
        const int g = (int)(L % ngrp), off = (int)(L / ngrp), rpg = nM / ngrp;
        u.pm = g * rpg + off % rpg; u.pn = off / rpg; return true;
    }
    __device__ __forceinline__ void a_ready(const Unit&) const {}
    __device__ __forceinline__ void done(const Unit&) const {}
};
struct StaticOrder {
    int nM, nN, nwg, G, c;
    __host__ __device__ void init(int M, int N, int G_, int c_) { nM = M / BM; nN = N / BM; nwg = nM * nN; G = G_; c = c_; }
    __host__ __device__ bool next(int i, Unit& u) const {
        const long L = (long)i * G + c; if (L >= nwg) return false;
        int wgid = (int)L; { const int q = nwg / NXCD, r = nwg % NXCD, xcd = wgid % NXCD, off = wgid / NXCD; wgid = (xcd < r ? xcd * (q + 1) : r * (q + 1) + (xcd - r) * q) + off; }
        const int nig = WGM * nN, gid = wgid / nig, fm = gid * WGM, gsz = (nM - fm) < WGM ? (nM - fm) : WGM;
        u.pm = fm + ((wgid % nig) % gsz); u.pn = (wgid % nig) / gsz; return true;
    }
    __device__ __forceinline__ void a_ready(const Unit&) const {}
    __device__ __forceinline__ void done(const Unit&) const {}
};

__device__ __forceinline__ unsigned cvt_pk_bf16(float lo, float hi) { unsigned r; asm volatile("v_cvt_pk_bf16_f32 %0, %1, %2" : "=v"(r) : "v"(lo), "v"(hi)); return r; }

struct EpiScaleBf16 {
    static constexpr bool PERM = true, AFTER_DRAIN = false;
    bf16_t* O; int ldc; const float* ss;
    __device__ __forceinline__ void operator()(const f32x4 (&acc)[2][2][4][2], const Unit& u, int wr, int wc, int fr, int fq) const {
        const int row0 = u.pm * BM + wr * 64 + fr; const int col0 = u.pn * BM + wc * 32 + 8 * fq;
        float scv[2][4];
#pragma unroll
        for (int ai = 0; ai < 2; ++ai)
#pragma unroll
            for (int m = 0; m < 4; ++m) scv[ai][m] = ss[row0 + ai * HALF + m * 16];
#pragma unroll
        for (int ai = 0; ai < 2; ++ai)
#pragma unroll
            for (int m = 0; m < 4; ++m) { const int row = row0 + ai * HALF + m * 16; const float sc = rsqrtf(scv[ai][m] * (1.0f / 1024.0f) + EPS);
                bf16_t* rowp = O + (size_t)row * ldc + col0;
#pragma unroll
                for (int bj = 0; bj < 2; ++bj) { const f32x4 v0 = acc[ai][bj][m][0] * sc, v1 = acc[ai][bj][m][1] * sc;
                    u32x4 w; w.x = cvt_pk_bf16(v0[0], v0[1]); w.y = cvt_pk_bf16(v0[2], v0[3]); w.z = cvt_pk_bf16(v1[0], v1[1]); w.w = cvt_pk_bf16(v1[2], v1[3]);
                    *(u32x4*)(rowp + bj * HALF) = w; } }
    }
};
struct EpiProj {
    static constexpr bool PERM = true, AFTER_DRAIN = false;
    bf16_t* O; const float* ss; const float* lb;
    __device__ __forceinline__ void operator()(const f32x4 (&acc)[2][2][4][2], const Unit& u, int wr, int wc, int fr, int fq) const {
        const int row0 = u.pm * BM + wr * 64 + fr; const int colt = u.pn * BM; const int col0 = colt + wc * 32 + 8 * fq;
        const int kind = colt < O_HQ ? 0 : (colt < O_HF ? 1 : (colt < O_HI ? 2 : 3));
        f32x4 lbv[2][2];
        if (kind == 2) {
#pragma unroll
            for (int bj = 0; bj < 2; ++bj)
#pragma unroll
                for (int n = 0; n < 2; ++n) lbv[bj][n] = *(const f32x4*)(lb + (col0 - O_HF) + bj * HALF + 4 * n);
        }
        float scv[2][4];
#pragma unroll
        for (int ai = 0; ai < 2; ++ai)
#pragma unroll
            for (int m = 0; m < 4; ++m) scv[ai][m] = ss[row0 + ai * HALF + m * 16];
#pragma unroll
        for (int ai = 0; ai < 2; ++ai)
#pragma unroll
            for (int m = 0; m < 4; ++m) { const int row = row0 + ai * HALF + m * 16; const float sc = rsqrtf(scv[ai][m] * (1.0f / 1024.0f) + EPS);
                bf16_t* rowp = O + (size_t)row * P_IN + col0;
#pragma unroll
                for (int bj = 0; bj < 2; ++bj) { f32x4 v0 = acc[ai][bj][m][0] * sc, v1 = acc[ai][bj][m][1] * sc;
                    if (kind == 0) {
#pragma unroll
                        for (int i = 0; i < 4; ++i) { v0[i] = v0[i] * __builtin_amdgcn_rcpf(1.f + __expf(-v0[i])); v1[i] = v1[i] * __builtin_amdgcn_rcpf(1.f + __expf(-v1[i])); }
                    } else if (kind == 1) {
#pragma unroll
                        for (int i = 0; i < 4; ++i) { v0[i] = v0[i] * 0.08838834764831845f * __builtin_amdgcn_rcpf(1.f + __expf(-v0[i])); v1[i] = v1[i] * 0.08838834764831845f * __builtin_amdgcn_rcpf(1.f + __expf(-v1[i])); }
                    } else if (kind == 2) {
#pragma unroll
                        for (int i = 0; i < 4; ++i) {
                            { const float f = v0[i], lbx = lbv[bj][0][i]; const float e1 = __expf(-fabsf(f)), inv = __builtin_amdgcn_rcpf(1.f + e1); const float sg = f >= 0.f ? inv : e1 * inv; const float ls = fminf(f, 0.f) - __logf(1.f + e1);
                              v0[i] = (lbx == 0.f ? ls : __logf(lbx + (1.f - lbx) * sg)) * 1.4426950408889634f; }
                            { const float f = v1[i], lbx = lbv[bj][1][i]; const float e1 = __expf(-fabsf(f)), inv = __builtin_amdgcn_rcpf(1.f + e1); const float sg = f >= 0.f ? inv : e1 * inv; const float ls = fminf(f, 0.f) - __logf(1.f + e1);
                              v1[i] = (lbx == 0.f ? ls : __logf(lbx + (1.f - lbx) * sg)) * 1.4426950408889634f; } }
                    }
                    u32x4 w; w.x = cvt_pk_bf16(v0[0], v0[1]); w.y = cvt_pk_bf16(v0[2], v0[3]); w.z = cvt_pk_bf16(v1[0], v1[1]); w.w = cvt_pk_bf16(v1[2], v1[3]);
                    *(u32x4*)(rowp + bj * HALF) = w; } }
    }
};
template <bool FIRST> struct EpiResid {
    static constexpr bool PERM = true, AFTER_DRAIN = false;
    const float* xin; float* xout; bf16_t* xb; float* ss;
    __device__ __forceinline__ void operator()(const f32x4 (&acc)[2][2][4][2], const Unit& u, int wr, int wc, int fr, int fq) const {
        const int row0 = u.pm * BM + wr * 64 + fr; const int col0 = u.pn * BM + wc * 32 + 8 * fq;
        u32x4 xw[2][4][2];
#pragma unroll
        for (int ai = 0; ai < 2; ++ai)
#pragma unroll
            for (int m = 0; m < 4; ++m)
#pragma unroll
                for (int bj = 0; bj < 2; ++bj) xw[ai][m][bj] = *(const u32x4*)(xb + (size_t)(row0 + ai * HALF + m * 16) * D_MODEL + col0 + bj * HALF);
#pragma unroll
        for (int ai = 0; ai < 2; ++ai)
#pragma unroll
            for (int m = 0; m < 4; ++m) { const int row = row0 + ai * HALF + m * 16; float s = 0.f;
#pragma unroll
                for (int bj = 0; bj < 2; ++bj) {
                    const u32x4 w = xw[ai][m][bj];
                    const f32x4 v0 = (f32x4){__uint_as_float(w.x << 16), __uint_as_float(w.x & 0xffff0000u), __uint_as_float(w.y << 16), __uint_as_float(w.y & 0xffff0000u)} + acc[ai][bj][m][0];
                    const f32x4 v1 = (f32x4){__uint_as_float(w.z << 16), __uint_as_float(w.z & 0xffff0000u), __uint_as_float(w.w << 16), __uint_as_float(w.w & 0xffff0000u)} + acc[ai][bj][m][1];
                    s += (v0[0] * v0[0] + v0[1] * v0[1]) + (v0[2] * v0[2] + v0[3] * v0[3]) + (v1[0] * v1[0] + v1[1] * v1[1]) + (v1[2] * v1[2] + v1[3] * v1[3]);
                    xw[ai][m][bj] = (u32x4){cvt_pk_bf16(v0[0], v0[1]), cvt_pk_bf16(v0[2], v0[3]), cvt_pk_bf16(v1[0], v1[1]), cvt_pk_bf16(v1[2], v1[3])}; }
                s += __shfl_xor(s, 16); s += __shfl_xor(s, 32);
                if (fq == 0) atomicAdd(ss + row, s); }
#pragma unroll
        for (int ai = 0; ai < 2; ++ai)
#pragma unroll
            for (int m = 0; m < 4; ++m)
#pragma unroll
                for (int bj = 0; bj < 2; ++bj) *(u32x4*)(xb + (size_t)(row0 + ai * HALF + m * 16) * D_MODEL + col0 + bj * HALF) = xw[ai][m][bj];
    }
};

template <class Epi, class Sched, bool ALIGN_EPI = false, bool SP2 = false>
__device__ __forceinline__ void gemm_phase(LAS unsigned char* lds, const Gemm g, const Sched& S, const Epi& E) {
    const int tid = threadIdx.x, wid = __builtin_amdgcn_readfirstlane(tid >> 6), lane = tid & 63, wr = wid >> 2, wc = wid & 3, fr = lane & 15, fq = lane >> 4;
    const int K = g.K, nt = K / BK, lda = g.lda;
    unsigned voffA[2], voffB[2];
#pragma unroll
    for (int i = 0; i < 2; ++i) { int R, C; stage_rc(tid * 16 + i * 8192, R, C); const int Rb = Epi::PERM ? ((R & ~31) + perm32(R & 31)) : R;
        voffA[i] = (unsigned)(R * lda + C) * 2u; voffB[i] = (unsigned)(Rb * K + C) * 2u; }
    const size_t kstep = (size_t)(BK * 2);
    const size_t hstepA = (size_t)HALF * lda * 2, hstepB = (size_t)HALF * K * 2;
    const size_t tstepA = 2 * hstepA, tstepB = 2 * hstepB;
    const unsigned ldsw = (unsigned)wid * 1024u;
    const int aoff = lds_byte(wr * 64 + fr, fq * 8), boff = lds_byte(wc * 32 + fr, fq * 8);
#define PG8_SA(b, h) (((b) * 2 + (h)) * HTB)
#define PG8_SB(b, h) ((4 + (b) * 2 + (h)) * HTB)
#define PG8_STAGE(bufoff, gbase, voff) do { _Pragma("unroll") for (int _i = 0; _i < 2; ++_i) \
        __builtin_amdgcn_global_load_lds((const unsigned*)((const char*)(gbase) + (voff)[_i]), (LAS unsigned*)(lds + (bufoff) + ldsw + _i * 8192), 16, 0, 0); } while (0)
#define PG8_LDA(dst, b, h) do { _Pragma("unroll") for (int m = 0; m < 4; ++m) _Pragma("unroll") for (int k = 0; k < 2; ++k) dst[m][k] = *(const LAS bf16x8*)(lds + PG8_SA(b, h) + aoff + m * 2048 + k * 1024); } while (0)
#define PG8_LDB(dst, b, h) do { _Pragma("unroll") for (int n = 0; n < 2; ++n) _Pragma("unroll") for (int k = 0; k < 2; ++k) dst[n][k] = *(const LAS bf16x8*)(lds + PG8_SB(b, h) + boff + n * 2048 + k * 1024); } while (0)
#define PG8_MMA(ai, bj, At, Bt) do { __builtin_amdgcn_s_setprio(1); _Pragma("unroll") for (int m = 0; m < 4; ++m) _Pragma("unroll") for (int n = 0; n < 2; ++n) _Pragma("unroll") for (int k = 0; k < 2; ++k) \
        acc[ai][bj][m][n] = __builtin_amdgcn_mfma_f32_16x16x32_bf16(Bt[n][k], At[m][k], acc[ai][bj][m][n], 0, 0, 0); __builtin_amdgcn_s_setprio(0); } while (0)
#define PG8_WAIT_V(n) asm volatile("s_waitcnt vmcnt(" #n ")" ::: "memory")
#define PG8_WAIT_L(n) asm volatile("s_waitcnt lgkmcnt(" #n ")" ::: "memory")
#define PG8_BAR __builtin_amdgcn_s_barrier()
#define PG8_SCHED __builtin_amdgcn_sched_barrier(0)
    Unit cur, nxt; int ui = 0;
    if (!S.next(0, cur)) return;
    f32x4 acc[2][2][4][2];
#pragma unroll
    for (int a = 0; a < 2; ++a)
#pragma unroll
        for (int b = 0; b < 2; ++b)
#pragma unroll
            for (int m = 0; m < 4; ++m)
#pragma unroll
                for (int n = 0; n < 2; ++n) acc[a][b][m][n] = (f32x4){0.f, 0.f, 0.f, 0.f};
    bf16x8 At[4][2], B0[2][2], B1[2][2];
    const char* cA = (const char*)g.A + (size_t)cur.pm * tstepA; const char* cB = (const char*)g.Bt + (size_t)cur.pn * tstepB;
    S.a_ready(cur);
    if constexpr (SP2) {
        PG8_STAGE(PG8_SB(0, 0), cB, voffB); PG8_STAGE(PG8_SB(0, 1), cB + hstepB, voffB); PG8_STAGE(PG8_SA(0, 0), cA, voffA); PG8_STAGE(PG8_SA(0, 1), cA + hstepA, voffA);
        if (wr == 1) PG8_BAR;
        PG8_WAIT_V(2); PG8_BAR;
        PG8_STAGE(PG8_SB(1, 0), cB + kstep, voffB); PG8_STAGE(PG8_SA(1, 0), cA + kstep, voffA); PG8_STAGE(PG8_SB(1, 1), cB + hstepB + kstep, voffB);
        PG8_WAIT_V(6); PG8_BAR;
    } else {
        PG8_STAGE(PG8_SB(0, 0), cB, voffB); PG8_STAGE(PG8_SA(0, 0), cA, voffA); PG8_STAGE(PG8_SB(0, 1), cB + hstepB, voffB); PG8_STAGE(PG8_SA(0, 1), cA + hstepA, voffA);
        if (wr == 1) PG8_BAR;
        PG8_WAIT_V(4); PG8_BAR;
        PG8_STAGE(PG8_SB(1, 0), cB + kstep, voffB); PG8_STAGE(PG8_SA(1, 0), cA + kstep, voffA); PG8_STAGE(PG8_SB(1, 1), cB + hstepB + kstep, voffB);
        PG8_WAIT_V(6); PG8_BAR;
    }
    for (;;) {
        const bool has_next = S.next(ui + 1, nxt);
        const char* nA = has_next ? (const char*)g.A + (size_t)nxt.pm * tstepA : cA; const char* nB = has_next ? (const char*)g.Bt + (size_t)nxt.pn * tstepB : cB;
        for (int t = 0; t < nt; t += 2) {
            const bool last = (t == nt - 2);
            const char* a1 = cA + (size_t)(t + 1) * kstep;
            const char* a2 = last ? nA : cA + (size_t)(t + 2) * kstep; const char* b2 = last ? nB : cB + (size_t)(t + 2) * kstep;
            const char* a3 = a2 + kstep; const char* b3 = b2 + kstep;
            if (last && has_next) S.a_ready(nxt);
            if constexpr (SP2) {
            PG8_LDB(B0, 0, 0); PG8_LDB(B1, 0, 1); PG8_SCHED; PG8_LDA(At, 0, 0); PG8_STAGE(PG8_SA(1, 1), a1 + hstepA, voffA);
            PG8_WAIT_V(8); PG8_WAIT_L(0); PG8_BAR; PG8_MMA(0, 0, At, B0); PG8_MMA(0, 1, At, B1); PG8_BAR; PG8_SCHED;
            PG8_LDA(At, 0, 1); PG8_STAGE(PG8_SB(0, 0), b2, voffB); PG8_STAGE(PG8_SB(0, 1), b2 + hstepB, voffB); PG8_STAGE(PG8_SA(0, 0), a2, voffA);
            PG8_WAIT_V(8); PG8_WAIT_L(0); PG8_BAR; PG8_MMA(1, 0, At, B0); PG8_MMA(1, 1, At, B1); PG8_BAR; PG8_SCHED;
            PG8_LDB(B0, 1, 0); PG8_LDB(B1, 1, 1); PG8_SCHED; PG8_LDA(At, 1, 0); PG8_STAGE(PG8_SA(0, 1), a2 + hstepA, voffA);
            PG8_WAIT_V(8); PG8_WAIT_L(0); PG8_BAR; PG8_MMA(0, 0, At, B0); PG8_MMA(0, 1, At, B1); PG8_BAR; PG8_SCHED;
            PG8_LDA(At, 1, 1); PG8_STAGE(PG8_SB(1, 0), b3, voffB); PG8_STAGE(PG8_SB(1, 1), b3 + hstepB, voffB); PG8_STAGE(PG8_SA(1, 0), a3, voffA);
            PG8_WAIT_V(8); PG8_WAIT_L(0); PG8_BAR; PG8_MMA(1, 0, At, B0); PG8_MMA(1, 1, At, B1); PG8_BAR; PG8_SCHED;
            } else {
            PG8_LDB(B0, 0, 0); PG8_SCHED; PG8_LDA(At, 0, 0); PG8_STAGE(PG8_SA(1, 1), a1 + hstepA, voffA);
            PG8_WAIT_L(8); PG8_BAR; PG8_WAIT_L(0); PG8_MMA(0, 0, At, B0); PG8_BAR; PG8_SCHED;
            PG8_LDB(B1, 0, 1); PG8_STAGE(PG8_SB(0, 0), b2, voffB);
            PG8_BAR; PG8_WAIT_L(0); PG8_MMA(0, 1, At, B1); PG8_BAR;
            PG8_LDA(At, 0, 1); PG8_STAGE(PG8_SA(0, 0), a2, voffA);
            PG8_BAR; PG8_WAIT_L(0); PG8_MMA(1, 0, At, B0); PG8_BAR; PG8_SCHED;
            PG8_STAGE(PG8_SB(0, 1), b2 + hstepB, voffB);
            PG8_WAIT_V(6); PG8_BAR; PG8_MMA(1, 1, At, B1); PG8_BAR;
            PG8_LDB(B0, 1, 0); PG8_SCHED; PG8_LDA(At, 1, 0); PG8_STAGE(PG8_SA(0, 1), a2 + hstepA, voffA);
            PG8_WAIT_L(8); PG8_BAR; PG8_WAIT_L(0); PG8_MMA(0, 0, At, B0); PG8_BAR; PG8_SCHED;
            PG8_LDB(B1, 1, 1); PG8_STAGE(PG8_SB(1, 0), b3, voffB);
            PG8_BAR; PG8_WAIT_L(0); PG8_MMA(0, 1, At, B1); PG8_BAR;
            PG8_LDA(At, 1, 1); PG8_STAGE(PG8_SA(1, 0), a3, voffA);
            PG8_BAR; PG8_WAIT_L(0); PG8_MMA(1, 0, At, B0); PG8_BAR; PG8_SCHED;
            PG8_STAGE(PG8_SB(1, 1), b3 + hstepB, voffB);
            PG8_WAIT_V(6); PG8_BAR; PG8_MMA(1, 1, At, B1); PG8_BAR;
            }
        }
        if constexpr (ALIGN_EPI) { if (wr == 0) PG8_BAR; }
        if constexpr (!Epi::AFTER_DRAIN) { E(acc, cur, wr, wc, fr, fq); S.done(cur); }
        if (!has_next) break;
#pragma unroll
        for (int a = 0; a < 2; ++a)
#pragma unroll
            for (int b = 0; b < 2; ++b)
#pragma unroll
                for (int m = 0; m < 4; ++m)
#pragma unroll
                    for (int n = 0; n < 2; ++n) acc[a][b][m][n] = (f32x4){0.f, 0.f, 0.f, 0.f};
        cur = nxt; cA = nA; cB = nB; ++ui;
        if constexpr (ALIGN_EPI) { if (wr == 1) PG8_BAR; }
    }
    PG8_WAIT_V(0);
    if constexpr (!ALIGN_EPI) { if (wr == 0) PG8_BAR; }
    PG8_BAR;
#undef PG8_SA
#undef PG8_SB
#undef PG8_STAGE
#undef PG8_LDA
#undef PG8_LDB
#undef PG8_MMA
#undef PG8_WAIT_V
#undef PG8_WAIT_L
#undef PG8_BAR
#undef PG8_SCHED
}
}

namespace xattn {
using bf16 = __hip_bfloat16;
constexpr int D = 128, NW = 8, QBLK = 32, KVBLK = 64;
constexpr float SCALE = 0.088388347648318440f;
constexpr float THR = 8.f;
constexpr int SDEPTH = 1;
constexpr int LDQ = P_IN, LDK = 2048;
constexpr size_t SHM_V = KVBLK * D * 2, SHM_K = KVBLK * D * 2, SHM_ATTN = 2 * SHM_V + 2 * SHM_K + NW * 64 * 4;
using s16x4 = __attribute__((ext_vector_type(4))) short;
using f32x16 = __attribute__((ext_vector_type(16))) float;
#define KSWZ(row, colB) ((row) * 256 + ((colB) ^ (((row) & 7) << 4)))
#define SBAR() __builtin_amdgcn_sched_barrier(0)
__device__ __forceinline__ int crow(int r, int hi) { return (r & 3) + 8 * (r >> 2) + 4 * hi; }
__device__ __forceinline__ unsigned cvtpk(float lo, float hi) { unsigned r; asm volatile("v_cvt_pk_bf16_f32 %0, %1, %2" : "=v"(r) : "v"(lo), "v"(hi)); return r; }
__device__ __forceinline__ bf16x8 ld8(const bf16* p) { return *reinterpret_cast<const bf16x8*>(p); }

__device__ __forceinline__ void partialSM(f32x16& p0, f32x16& p1, float& m_reg, float& mn, float& alpha) {
  constexpr float C = SCALE * 1.4426950408889634f;
  float pmax = p0[0]; for (int r = 1; r < 16; ++r) pmax = fmaxf(pmax, p0[r]); for (int r = 0; r < 16; ++r) pmax = fmaxf(pmax, p1[r]);
  { auto rr = __builtin_amdgcn_permlane32_swap(__float_as_uint(pmax), __float_as_uint(pmax), false, false);
    pmax = fmaxf(__uint_as_float(rr[0]), __uint_as_float(rr[1])); }
  if (__builtin_expect(__all(pmax - m_reg <= THR / SCALE), 1)) { mn = m_reg; alpha = 1.f; }
  else { mn = fmaxf(m_reg, pmax); alpha = __builtin_amdgcn_exp2f((m_reg - mn) * C); m_reg = mn; }
  float mnC = -mn * C;
  for (int r = 0; r < 16; ++r) p0[r] = fmaf(p0[r], C, mnC); for (int r = 0; r < 16; ++r) p1[r] = fmaf(p1[r], C, mnC);
  for (int r = 0; r < 16; ++r) p0[r] = __builtin_amdgcn_exp2f(p0[r]);
}
__device__ __forceinline__ void finishSM(f32x16& p0, f32x16& p1, float alpha, float& l_reg, bf16x8& pa0, bf16x8& pa1, bf16x8& pa2, bf16x8& pa3) {
  for (int r = 0; r < 16; ++r) p1[r] = __builtin_amdgcn_exp2f(p1[r]);
  float ps = 0; for (int r = 0; r < 16; ++r) ps += p0[r]; for (int r = 0; r < 16; ++r) ps += p1[r];
  { auto rr = __builtin_amdgcn_permlane32_swap(__float_as_uint(ps), __float_as_uint(ps), false, false);
    ps = __uint_as_float(rr[0]) + __uint_as_float(rr[1]); }
  l_reg = l_reg * alpha + ps;
#define PK4(P, BASE, OUT) do { unsigned a0 = cvtpk(P[BASE + 0], P[BASE + 1]), a1 = cvtpk(P[BASE + 2], P[BASE + 3]);   \
    unsigned b0 = cvtpk(P[BASE + 4], P[BASE + 5]), b1 = cvtpk(P[BASE + 6], P[BASE + 7]);                              \
    auto r0 = __builtin_amdgcn_permlane32_swap(a0, b0, false, false); auto r1 = __builtin_amdgcn_permlane32_swap(a1, b1, false, false); \
    u32x4 w = {r0[0], r1[0], r0[1], r1[1]}; OUT = *reinterpret_cast<bf16x8*>(&w); } while (0)
  PK4(p0, 0, pa0); PK4(p0, 8, pa1); PK4(p1, 0, pa2); PK4(p1, 8, pa3);
#undef PK4
}
__device__ __forceinline__ void qkt(f32x16& p0, f32x16& p1, const bf16* Ks, const bf16x8* qr, int r32, int hi) {
  p0 = f32x16{}; p1 = f32x16{};
  for (int d0 = 0; d0 < 8; ++d0) { int cb = (d0 * 16 + hi * 8) * 2;
    bf16x8 b0 = *reinterpret_cast<const bf16x8*>((const char*)Ks + KSWZ(r32, cb));
    bf16x8 b1 = *reinterpret_cast<const bf16x8*>((const char*)Ks + KSWZ(32 + r32, cb));
    p0 = __builtin_amdgcn_mfma_f32_32x32x16_bf16(b0, qr[d0], p0, 0, 0, 0);
    p1 = __builtin_amdgcn_mfma_f32_32x32x16_bf16(b1, qr[d0], p1, 0, 0, 0); }
}
__device__ __forceinline__ int v_st(int k, int c) { const int kk = (k & ~0xC) | ((k & 4) << 1) | ((k & 8) >> 1); return ((kk >> 3) * 4 + (c >> 5)) * 512 + ((kk & 7) * 32 + (c & 31)) * 2; }
__device__ __forceinline__ int v_rd_base(int lane) { return ((lane & 3) << 3) | (((lane >> 2) & 3) << 6) | (((lane >> 4) & 1) << 5) | (((lane >> 5) & 1) << 8); }
constexpr int v_rd_off(int d0, int ks, int half) { return d0 * 512 + ks * 4096 + half * 2048; }
template <int OFF> __device__ __forceinline__ s16x4 tr_read(int vb) {
  s16x4 r; asm volatile("ds_read_b64_tr_b16 %0, %1 offset:%2" : "=&v"(r) : "v"(vb), "i"(OFF) : "memory"); return r;
}
template <int D0> __device__ __forceinline__ void pv_one(f32x16& od, int vb, bf16x8 pa0, bf16x8 pa1, bf16x8 pa2, bf16x8 pa3) {
  const s16x4 l0 = tr_read<v_rd_off(D0, 0, 0)>(vb), h0 = tr_read<v_rd_off(D0, 0, 1)>(vb), l1 = tr_read<v_rd_off(D0, 1, 0)>(vb), h1 = tr_read<v_rd_off(D0, 1, 1)>(vb);
  const s16x4 l2 = tr_read<v_rd_off(D0, 2, 0)>(vb), h2 = tr_read<v_rd_off(D0, 2, 1)>(vb), l3 = tr_read<v_rd_off(D0, 3, 0)>(vb), h3 = tr_read<v_rd_off(D0, 3, 1)>(vb);
  asm volatile("s_waitcnt lgkmcnt(0)" ::: "memory"); SBAR();
#define PK(L, H) (bf16x8){L[0], L[1], L[2], L[3], H[0], H[1], H[2], H[3]}
  od = __builtin_amdgcn_mfma_f32_32x32x16_bf16(pa0, PK(l0, h0), od, 0, 0, 0);
  od = __builtin_amdgcn_mfma_f32_32x32x16_bf16(pa1, PK(l1, h1), od, 0, 0, 0);
  od = __builtin_amdgcn_mfma_f32_32x32x16_bf16(pa2, PK(l2, h2), od, 0, 0, 0);
  od = __builtin_amdgcn_mfma_f32_32x32x16_bf16(pa3, PK(l3, h3), od, 0, 0, 0);
#undef PK
}
__device__ __forceinline__ void pv_d0(f32x16* o, int vb, bf16x8 pa0, bf16x8 pa1, bf16x8 pa2, bf16x8 pa3) {
  pv_one<0>(o[0], vb, pa0, pa1, pa2, pa3); pv_one<1>(o[1], vb, pa0, pa1, pa2, pa3); pv_one<2>(o[2], vb, pa0, pa1, pa2, pa3); pv_one<3>(o[3], vb, pa0, pa1, pa2, pa3);
}
constexpr int XA_V = 0, XA_K = 4 * (int)SHM_V, XA_WS = XA_K + 4 * (int)SHM_K, XA_ST = XA_WS + NW * 64 * 4, XA_END = XA_ST + NW * 2048;
template <int NQT>
__device__ __forceinline__ void attn_unit(const bf16* Qb, const bf16* Kh, const bf16* Vh, bf16_t* Gb, const float* nw, char* lds) {
  const int tid = threadIdx.x, wid = tid >> 6, lane = tid & 63, r32 = lane & 31, hi = lane >> 5;
  bf16* V_lds = (bf16*)(lds + XA_V); bf16* K_lds = (bf16*)(lds + XA_K);
  float* ws = (float*)(lds + XA_WS) + wid * 64; float* li_l = ws; float* al_l = ws + 32;
  char* stg = lds + XA_ST + wid * 2048;
  {
    const int sr = tid >> 4, sc = (tid & 15) * 8, vst0 = v_st(sr, sc), vst1 = v_st(32 + sr, sc), kc = sc * 2;
    bf16x8 vs[4][2], ks[4][2];
#pragma unroll
    for (int t = 0; t < 4; ++t) { vs[t][0] = ld8(&Vh[(long)(t * 64 + sr) * LDK + sc]); vs[t][1] = ld8(&Vh[(long)(t * 64 + 32 + sr) * LDK + sc]);
      ks[t][0] = ld8(&Kh[(long)(t * 64 + sr) * LDK + sc]); ks[t][1] = ld8(&Kh[(long)(t * 64 + 32 + sr) * LDK + sc]); }
#pragma unroll
    for (int t = 0; t < 4; ++t) { *(bf16x8*)((char*)V_lds + t * SHM_V + vst0) = vs[t][0]; *(bf16x8*)((char*)V_lds + t * SHM_V + vst1) = vs[t][1];
      *(bf16x8*)((char*)K_lds + t * SHM_K + KSWZ(sr, kc)) = ks[t][0]; *(bf16x8*)((char*)K_lds + t * SHM_K + KSWZ(32 + sr, kc)) = ks[t][1]; }
  }
  const int vb0 = (int)(uintptr_t)V_lds + v_rd_base(lane);
  bf16x8 qr[8];
  { const bf16* Qw = Qb + (long)(wid * QBLK + r32) * LDQ + hi * 8;
#pragma unroll
    for (int d0 = 0; d0 < 8; ++d0) qr[d0] = ld8(Qw + d0 * 16); }
  __syncthreads();
  float nwv[4];
#pragma unroll
  for (int d0 = 0; d0 < 4; ++d0) nwv[d0] = nw[d0 * 32 + r32];
#define RESC(a) do { if (__any((a) < 1.f)) { if (hi == 0) al_l[r32] = (a); asm volatile("s_waitcnt lgkmcnt(0)" ::: "memory"); \
    for (int d = 0; d < 4; ++d) for (int r = 0; r < 16; ++r) o[d][r] *= al_l[crow(r, hi)]; } } while (0)
#pragma unroll 1
  for (int qt = 0; qt < NQT; ++qt) {
    float m_reg = -1e30f, l_reg = 0; f32x16 o[4] = {};
    f32x16 pA0, pA1; float mnA, alA; bf16x8 pa0, pa1, pa2, pa3;
#pragma unroll
    for (int j = 0; j < 4; ++j) {
      SBAR(); qkt(pA0, pA1, (bf16*)((char*)K_lds + j * SHM_K), qr, r32, hi);
      if (j == 3 && qt + 1 < NQT) {
        const bf16* Qw = Qb + (long)((qt + 1) * 256 + wid * QBLK + r32) * LDQ + hi * 8;
#pragma unroll
        for (int d0 = 0; d0 < 8; ++d0) qr[d0] = ld8(Qw + d0 * 16); }
      partialSM(pA0, pA1, m_reg, mnA, alA); RESC(alA);
      finishSM(pA0, pA1, alA, l_reg, pa0, pa1, pa2, pa3); SBAR();
      pv_d0(o, vb0 + j * (int)SHM_V, pa0, pa1, pa2, pa3);
    }
    bf16_t* Gw = Gb + (long)(qt * 256 + wid * QBLK) * LDQ;
    u32x4 gt[4][2];
#pragma unroll
    for (int d0 = 0; d0 < 4; ++d0)
#pragma unroll
      for (int k = 0; k < 2; ++k) { const int id = lane + 64 * k; gt[d0][k] = *(const u32x4*)(Gw + (long)(id >> 2) * LDQ + d0 * 32 + (id & 3) * 8); }
    if (hi == 0) li_l[r32] = l_reg; asm volatile("s_waitcnt lgkmcnt(0)" ::: "memory");
    float ssq[16];
#pragma unroll
    for (int r = 0; r < 16; ++r) { const float lr = li_l[crow(r, hi)]; float sq = 0.f;
#pragma unroll
      for (int d0 = 0; d0 < 4; ++d0) sq += o[d0][r] * o[d0][r];
      sq += swz_xor<1>(sq); sq += swz_xor<2>(sq); sq += swz_xor<4>(sq); sq += swz_xor<8>(sq); sq += swz_xor<16>(sq); ssq[r] = rsqrtf(sq * (1.0f / 128.0f) + EPS * lr * lr); }
#pragma unroll
    for (int d0 = 0; d0 < 4; ++d0) {
#pragma unroll
      for (int r = 0; r < 16; ++r) *(unsigned short*)(stg + crow(r, hi) * 64 + r32 * 2) = (unsigned short)f2bf(o[d0][r] * ssq[r] * nwv[d0]);
      asm volatile("s_waitcnt lgkmcnt(0)" ::: "memory");
#pragma unroll
      for (int k = 0; k < 2; ++k) { const int id = lane + 64 * k; const u32x4 ov = *(const u32x4*)(stg + id * 16); const u32x4 g = gt[d0][k]; u32x4 w;
#pragma unroll
        for (int e = 0; e < 4; ++e) w[e] = pk2(__uint_as_float(ov[e] << 16) * __uint_as_float(g[e] << 16), __uint_as_float(ov[e] & 0xffff0000u) * __uint_as_float(g[e] & 0xffff0000u));
        *(u32x4*)(Gw + (long)(id >> 2) * LDQ + d0 * 32 + (id & 3) * 8) = w; }
      asm volatile("s_waitcnt lgkmcnt(0)" ::: "memory");
    }
  }
#undef RESC
}
#undef KSWZ
#undef SBAR
static_assert(XA_END <= SCAN_LDS, "xattn lds");
}

#define XB_TMO      128
#define XB_XCNT(j)  (256  + 64 * (j))
#define XB_XSUB(j)  (1280 + 64 * (j))
#define XB_XGEN(j)  (2304 + 64 * (j))
#define XB_TOP      3328
#define XB_TOPGEN   3392
#define XCD_BAR_WORDS 3456
#define XB_SPIN_CAP (1u << 22)
__device__ __forceinline__ unsigned xb_ld(unsigned* p)              { return __hip_atomic_load(p, __ATOMIC_RELAXED, __HIP_MEMORY_SCOPE_AGENT); }
__device__ __forceinline__ unsigned xb_add(unsigned* p, unsigned v) { return __hip_atomic_fetch_add(p, v, __ATOMIC_RELAXED, __HIP_MEMORY_SCOPE_AGENT); }
__device__ __forceinline__ unsigned xb_xcc_id() { return (unsigned)__builtin_amdgcn_s_getreg((3 << 11) | 20) & 0xFu; }
#define XB_SPIN(cond, bar) do { unsigned _sp = 0; while (cond) { __builtin_amdgcn_s_sleep(1); \
    if ((++_sp & 255u) == 0u) { if (xb_ld(&(bar)[XB_TMO])) break; if (_sp > XB_SPIN_CAP) { atomicAdd(&(bar)[XB_TMO], 1u); break; } } } } while (0)
struct XcdBarrier { unsigned* bar; unsigned x; volatile LAS unsigned* st; };
__device__ __forceinline__ XcdBarrier xcd_barrier_post(unsigned* bar, volatile LAS unsigned* st) {
    XcdBarrier b; b.bar = bar; b.x = xb_xcc_id(); b.st = st;
    if (threadIdx.x == 0) (void)xb_add(&bar[XB_XCNT(b.x)], 1u);
    return b;
}
__device__ __forceinline__ void xcd_barrier_complete(unsigned* bar, unsigned x, unsigned& nloc, unsigned& nx) {
    const unsigned G = gridDim.x * gridDim.y * gridDim.z;
    unsigned sum, cnt, mine, sp = 0u;
    for (;;) {
        sum = 0u; cnt = 0u; mine = 0u;
#pragma unroll
        for (unsigned j = 0; j < 16; ++j) { const unsigned c = xb_ld(&bar[XB_XCNT(j)]); sum += c; cnt += (c > 0u) ? 1u : 0u; mine = (j == x) ? c : mine; }
        if (sum == G) break;
        __builtin_amdgcn_s_sleep(1);
        if ((++sp & 255u) == 0u) { if (xb_ld(&bar[XB_TMO])) break; if (sp > XB_SPIN_CAP) { atomicAdd(&bar[XB_TMO], 1u); break; } }
    }
    nloc = mine > 0u ? mine : 1u; nx = cnt > 0u ? cnt : 1u;
}
__device__ __forceinline__ void xcd_barrier(const XcdBarrier& b) {
    asm volatile("s_waitcnt vmcnt(0)" ::: "memory");
    __syncthreads();
    if (threadIdx.x == 0) {
        unsigned* bar = b.bar;
        __builtin_amdgcn_s_waitcnt(0);
        unsigned nloc = b.st[0], nx = b.st[1];
        if (nloc == 0u) { xcd_barrier_complete(bar, b.x, nloc, nx); b.st[0] = nloc; b.st[1] = nx; }
        const unsigned old = xb_add(&bar[XB_XSUB(b.x)], 1u);
        const unsigned gen = old / nloc;
        if (old + 1u == (gen + 1u) * nloc) {
            __builtin_amdgcn_fence(__ATOMIC_RELEASE, "agent");
            asm volatile("s_waitcnt vmcnt(0)" ::: "memory");
            const unsigned og = xb_add(&bar[XB_TOP], 1u);
            const unsigned tg = og / nx;
            if (og + 1u == (tg + 1u) * nx) xb_add(&bar[XB_TOPGEN], 1u);
            else XB_SPIN(xb_ld(&bar[XB_TOPGEN]) == tg, bar);
            __builtin_amdgcn_fence(__ATOMIC_ACQUIRE, "agent");
            xb_add(&bar[XB_XGEN(b.x)], 1u);
            asm volatile("s_waitcnt vmcnt(0)" ::: "memory");
        } else {
            XB_SPIN(xb_ld(&bar[XB_XGEN(b.x)]) == gen, bar);
            __builtin_amdgcn_fence(__ATOMIC_ACQUIRE, "agent");
            asm volatile("s_waitcnt vmcnt(0)" ::: "memory");
        }
    }
    __syncthreads();
}

__device__ __forceinline__ void group_barrier(unsigned* cnt, unsigned* gen, unsigned k, unsigned gsz, unsigned* tmo, int coloc) {
    asm volatile("s_waitcnt vmcnt(0)" ::: "memory");
    __syncthreads();
    if (threadIdx.x == 0) {
        if (coloc) __builtin_amdgcn_fence(__ATOMIC_RELEASE, "workgroup"); else __builtin_amdgcn_fence(__ATOMIC_RELEASE, "agent");
        asm volatile("s_waitcnt vmcnt(0)" ::: "memory");
        const unsigned old = xb_add(cnt, 1u);
        if (old + 1u == gsz * k) (void)xb_add(gen, 1u);
        else { unsigned sp = 0; while (xb_ld(gen) < k) { __builtin_amdgcn_s_sleep(1);
                   if ((++sp & 255u) == 0u) { if (xb_ld(tmo)) break; if (sp > XB_SPIN_CAP) { atomicAdd(tmo, 1u); break; } } } }
        if (coloc) asm volatile("buffer_inv sc0" ::: "memory");
        else __builtin_amdgcn_fence(__ATOMIC_ACQUIRE, "agent");
        asm volatile("s_waitcnt vmcnt(0)" ::: "memory");
    }
    __syncthreads();
}

struct Params {
    const float* in[20]; float* out; unsigned char* ws; int ph_lo, ph_hi;
};
struct Ctx {
    LAS unsigned char* lds; int tid, lane, wave, G;
    int ngrp, gsz, grp, gj, coloc;
    const float* const* inp;
    float* out; unsigned char* ws;
};
#define F_IN(k) (F.inp[k])
#define F_x F_IN(0)
#define F_mem F_IN(1)
#define F_norm_w F_IN(2)
#define F_w_in F_IN(3)
#define F_lb_logits F_IN(4)
#define F_hgrn_norm_w F_IN(5)
#define F_conv_w F_IN(6)
#define F_conv_b F_IN(7)
#define F_wq F_IN(8)
#define F_wk F_IN(9)
#define F_wv F_IN(10)
#define F_w_gate F_IN(11)
#define F_b_gate F_IN(12)
#define F_ml_norm_w F_IN(13)
#define F_ml_skip F_IN(14)
#define F_mem_norm_w F_IN(15)
#define F_w_kv F_IN(16)
#define F_xa_norm_w F_IN(17)
#define F_w_out F_IN(18)
#define F_final_w F_IN(19)
#define F_ctl ((unsigned*)(F.ws + WS_CTL))
#define F_WinT ((bf16_t*)(F.ws + WS_WIN))
#define F_WkvT ((bf16_t*)(F.ws + WS_WKV))
#define F_WoutT ((bf16_t*)(F.ws + WS_WOUT))
#define F_memb ((bf16_t*)(F.ws + WS_MEMB))
#define F_mkv ((bf16_t*)(F.ws + WS_MKV))
#define F_xb ((bf16_t*)(F.ws + WS_XB))
#define F_proj ((bf16_t*)(F.ws + WS_PROJ))
#define F_ss0 ((float*)(F.ws + WS_SS0))
#define F_ss1 ((float*)(F.ws + WS_SS1))
#define F_ss2 ((float*)(F.ws + WS_SS2))
#define F_ssm ((float*)(F.ws + WS_SSM))
#define F_lb ((float*)(F.ws + WS_LB))
#define F_gates ((float*)(F.ws + WS_GATES))
#define F_g12 ((float*)(F.ws + WS_G12))
#define F_xcb ((bf16_t*)(F.ws + WS_XC))

__device__ __forceinline__ void transpose_item(const float* W, int ldw, int K, int k0, int nsrc, bf16_t* WT, int ndst, const float* kscale, LAS float* scr, int lane) {
    f32x4 v[8]; float sc[8];
#pragma unroll
    for (int i = 0; i < 8; ++i) { const int kk = 8 * i + (lane >> 3); v[i] = *(const f32x4*)(W + (size_t)(k0 + kk) * ldw + nsrc + 4 * (lane & 7)); sc[i] = kscale ? kscale[k0 + kk] : 1.f; }
#pragma unroll
    for (int i = 0; i < 8; ++i) { const int kk = 8 * i + (lane >> 3); LAS float* d = scr + kk * 33 + 4 * (lane & 7);
        d[0] = v[i][0] * sc[i]; d[1] = v[i][1] * sc[i]; d[2] = v[i][2] * sc[i]; d[3] = v[i][3] * sc[i]; }
    asm volatile("s_waitcnt lgkmcnt(0)" ::: "memory");
    const int c = lane & 7;
#pragma unroll
    for (int j = 0; j < 4; ++j) { const int n = (lane >> 3) + 8 * j; const LAS float* s = scr + (8 * c) * 33 + n;
        u32x4 o; o.x = pk2(s[0 * 33], s[1 * 33]); o.y = pk2(s[2 * 33], s[3 * 33]); o.z = pk2(s[4 * 33], s[5 * 33]); o.w = pk2(s[6 * 33], s[7 * 33]);
        *(u32x4*)(WT + (size_t)(ndst + n) * K + k0 + 8 * c) = o; }
    asm volatile("s_waitcnt lgkmcnt(0)" ::: "memory");
}

__device__ __forceinline__ void phase_rows(Ctx& F) {
    const int nx = M_TOK / F.ngrp, nm = M_MEM / F.ngrp, ntot = nx + nm, step = F.gsz * 8 * 4;
    f32x4 v[4][4], vn[4][4];
#define PREP_LOAD(dst, rb_) do { _Pragma("unroll") for (int q = 0; q < 4; ++q) { const int rl = (rb_) + q; const bool isx = rl < nx; const int r = isx ? F.grp * nx + rl : F.grp * nm + (rl - nx); \
        const f32x4* src = (const f32x4*)((isx ? F_x : F_mem) + (size_t)r * D_MODEL) + F.lane; \
        _Pragma("unroll") for (int j = 0; j < 4; ++j) dst[q][j] = src[64 * j]; } } while (0)
    int rb = (F.gj * 8 + F.wave) * 4;
    if (rb < ntot) PREP_LOAD(v, rb);
    for (; rb < ntot; rb += step) {
        const int rbn = rb + step < ntot ? rb + step : rb;
        PREP_LOAD(vn, rbn);
#pragma unroll
        for (int q = 0; q < 4; ++q) { const int rl = rb + q; const bool isx = rl < nx; const int r = isx ? F.grp * nx + rl : F.grp * nm + (rl - nx);
            u32x2* dst = (u32x2*)((isx ? F_xb : F_memb) + (size_t)r * D_MODEL) + F.lane; float s = 0.f;
#pragma unroll
            for (int j = 0; j < 4; ++j) { s += (v[q][j][0] * v[q][j][0] + v[q][j][1] * v[q][j][1]) + (v[q][j][2] * v[q][j][2] + v[q][j][3] * v[q][j][3]);
                u32x2 w; w.x = pk2(v[q][j][0], v[q][j][1]); w.y = pk2(v[q][j][2], v[q][j][3]); dst[64 * j] = w; }
            s = wave_sum(s);
            if (F.lane == 0) (isx ? F_ss0 : F_ssm)[r] = s; }
#pragma unroll
        for (int q = 0; q < 4; ++q)
#pragma unroll
            for (int j = 0; j < 4; ++j) v[q][j] = vn[q][j];
    }
#undef PREP_LOAD
}

constexpr int GXS = 1552, GTS = 3088;
constexpr int GIMG_BYTES = 9 * GTS + 2 * 768 * 4 + 768 * 4;
static_assert(GIMG_BYTES % 16 == 0 && 2 * GIMG_BYTES <= 2 * 768 * 16 * 4, "gate image");
__device__ __forceinline__ void phase_prep(Ctx& F) {
    LAS float* scr = (LAS float*)(F.lds + F.wave * 16384);
    const int gw = blockIdx.x * 8 + F.wave, NGW = F.G * 8;
    constexpr int I_IN = DEPTH * 16 * 176, I_KV = DEPTH * 16 * 32, I_OUT = DEPTH * 32 * 32;
    for (int it = gw; it < I_IN + I_KV + I_OUT; it += NGW) {
        int r = it;
        if (r < I_IN) { const int l = r / (16 * 176), rr = r % (16 * 176), kb = rr / 176, nb = rr % 176;
            transpose_item(F_w_in + (size_t)l * D_MODEL * P_IN, P_IN, D_MODEL, kb * 64, src_col(nb * 32), F_WinT + (size_t)l * P_IN * D_MODEL, nb * 32, F_norm_w + l * D_MODEL, scr, F.lane); continue; }
        r -= I_IN;
        if (r < I_KV) { const int l = r / (16 * 32), rr = r % (16 * 32), kb = rr / 32, nb = rr % 32;
            transpose_item(F_w_kv + (size_t)l * D_MODEL * 1024, 1024, D_MODEL, kb * 64, nb * 32, F_WkvT + (size_t)l * 1024 * D_MODEL, nb * 32, F_mem_norm_w + l * D_MODEL, scr, F.lane); continue; }
        r -= I_KV;
        { const int l = r / (32 * 32), rr = r % (32 * 32), kb = rr / 32, nb = rr % 32;
            transpose_item(F_w_out + (size_t)l * D_MIX * D_MODEL, D_MODEL, D_MIX, kb * 64, nb * 32, F_WoutT + (size_t)l * D_MODEL * D_MIX, nb * 32, nullptr, scr, F.lane); }
    }
    const int gt = blockIdx.x * 512 + F.tid, NGT = F.G * 512;
    for (int i = gt; i < 2 * M_TOK; i += NGT) F_ss1[i] = 0.f;
    for (int i = gt; i < DEPTH * 768; i += NGT) {
        const int l = i / 768, c = i % 768, g = c >> 2, ii = c & 3;
        const float* wq = F_wq + (l * 192 + g) * 16 + ii * 4; const float* wk = F_wk + (l * 192 + g) * 16 + ii * 4; const float* wv = F_wv + (l * 192 + g) * 16 + ii * 4;
        const float* wg = F_w_gate + (size_t)l * 2304 * 8;
        float g1[8], g2[8];
#pragma unroll
        for (int n = 0; n < 8; ++n) { g1[n] = 0.f; g2[n] = 0.f; }
#pragma unroll
        for (int o = 0; o < 4; ++o)
#pragma unroll
            for (int n = 0; n < 8; ++n) { g1[n] += wq[o] * wg[(4 * g + o) * 8 + n] + wk[o] * wg[(768 + 4 * g + o) * 8 + n]; g2[n] += wv[o] * wg[(1536 + 4 * g + o) * 8 + n]; }
        {
            unsigned char* img = F.ws + WS_G12 + (size_t)l * GIMG_BYTES;
#pragma unroll
            for (int n = 0; n < 8; ++n) { *(unsigned short*)(img + n * GTS + c * 2) = (unsigned short)f2bf(g1[n]); *(unsigned short*)(img + n * GTS + (768 + c) * 2) = (unsigned short)f2bf(g2[n]); }
            *(unsigned short*)(img + 8 * GTS + c * 2) = 0; *(unsigned short*)(img + 8 * GTS + (768 + c) * 2) = 0;
            const float* cwp = F_conv_w + l * 4 * 768 + c;
            ((unsigned*)(img + 9 * GTS))[c] = pk2(cwp[0], cwp[768]); ((unsigned*)(img + 9 * GTS))[768 + c] = pk2(cwp[2 * 768], cwp[3 * 768]);
            ((float*)(img + 9 * GTS + 2 * 768 * 4))[c] = F_conv_b[l * 768 + c]; }
    }
    for (int i = gt; i < 768; i += NGT) { const float l0 = F_lb_logits[i], l1 = F_lb_logits[768 + i]; const float mx = fmaxf(l0, l1);
        const float e0 = __expf(l0 - mx), e1 = __expf(l1 - mx); const float s0 = e0 / (e0 + e1), s1 = e1 / (e0 + e1);
        F_lb[i] = fmaxf(s0 - s0, 0.f); F_lb[768 + i] = fmaxf((s0 + s1) - s0, 0.f); }
}

constexpr int G_XT = 0, G_MT = G_XT + 32 * GXS, G_GT = G_MT + 32 * GXS, G_CW = G_GT + 9 * GTS, G_CB = G_CW + 2 * 768 * 4, G_RED = G_CB + 768 * 4, G_END = G_RED + 8 * 32 * 8 * 4;
static_assert(G_END <= MISC_OFF && (G_CW % 16) == 0 && (G_GT % 16) == 0 && G_CW == G_GT + 9 * GTS && G_CB == G_CW + 2 * 768 * 4, "gates lds");
__device__ __forceinline__ void phase_gates(Ctx& F, int l) {
    using f32x16 = __attribute__((ext_vector_type(16))) float;
    const int lane = F.lane, wave = F.wave, r32 = lane & 31, hh = lane >> 5;
    LAS unsigned char* L = F.lds;
    {
        const u32x4* src = (const u32x4*)(F.ws + WS_G12 + (size_t)l * GIMG_BYTES); u32x4 v[5];
#pragma unroll
        for (int k = 0; k < 5; ++k) { const int idx = F.tid + 512 * k; if (idx < GIMG_BYTES / 16) v[k] = src[idx]; }
#pragma unroll
        for (int k = 0; k < 5; ++k) { const int idx = F.tid + 512 * k; if (idx < GIMG_BYTES / 16) *(LAS u32x4*)(L + G_GT + idx * 16) = v[k]; }
    }
    __syncthreads();
    const float bgn = F_b_gate[l * 8 + (F.tid & 7)];
    u32x2 xq[2][3][5];
#define G_LOAD1(st_, pr) do { const int tok_ = 32 * (st_) + 2 * (wave + 8 * (pr)); \
        _Pragma("unroll") for (int gi = 0; gi < 3; ++gi) _Pragma("unroll") for (int j = 0; j < 5; ++j) \
        xq[pr][gi][j] = *(const u32x2*)(F_proj + (size_t)(tok_ - 3 + j > 0 ? tok_ - 3 + j : 0) * P_IN + O_MX + 4 * (lane + 64 * gi)); } while (0)
#define G_LOAD(st_) do { G_LOAD1(st_, 0); G_LOAD1(st_, 1); } while (0)
    const int NST = M_TOK / 32;
    const int st_end = (F.grp + 1) * (NST / F.ngrp);
    if (F.grp * (NST / F.ngrp) + F.gj < st_end) G_LOAD(F.grp * (NST / F.ngrp) + F.gj);
#pragma unroll 1
    for (int st = F.grp * (NST / F.ngrp) + F.gj; st < st_end; st += F.gsz) {
#pragma unroll
        for (int pr = 0; pr < 2; ++pr) {
            const int tl = 2 * (wave + 8 * pr), tok = 32 * st + tl;
            const int tseq = tok & (SEQ - 1);
#pragma unroll
            for (int gi = 0; gi < 3; ++gi) {
                const int c = 4 * (lane + 64 * gi);
#pragma unroll
                for (int j = 0; j < 3; ++j) { const bool z = tseq - 3 + j < 0;
                    xq[pr][gi][j].x = z ? 0u : xq[pr][gi][j].x; xq[pr][gi][j].y = z ? 0u : xq[pr][gi][j].y; }
                const f32x4 cbv = *(LAS const f32x4*)(L + G_CB + c * 4);
                const u32x4 w01 = *(LAS const u32x4*)(L + G_CW + c * 4), w23 = *(LAS const u32x4*)(L + G_CW + (768 + c) * 4);
                float xs0[4], xs1[4];
#pragma unroll
                for (int i = 0; i < 4; ++i) {
                    const int d = i >> 1; const unsigned sel = (i & 1) ? 0x07060302u : 0x05040100u;
                    const unsigned p01 = __builtin_amdgcn_perm(xq[pr][gi][1][d], xq[pr][gi][0][d], sel), p23 = __builtin_amdgcn_perm(xq[pr][gi][3][d], xq[pr][gi][2][d], sel);
                    const unsigned p12 = __builtin_amdgcn_perm(xq[pr][gi][2][d], xq[pr][gi][1][d], sel), p34 = __builtin_amdgcn_perm(xq[pr][gi][4][d], xq[pr][gi][3][d], sel);
                    const float a0 = dot2bf(p23, w23[i], dot2bf(p01, w01[i], cbv[i])), a1 = dot2bf(p34, w23[i], dot2bf(p12, w01[i], cbv[i]));
                    xs0[i] = a0 * rcp_f(1.f + __expf(-a0)); xs1[i] = a1 * rcp_f(1.f + __expf(-a1)); }
                const u32x2 w0 = {pk2(xs0[0], xs0[1]), pk2(xs0[2], xs0[3])}, w1 = {pk2(xs1[0], xs1[1]), pk2(xs1[2], xs1[3])};
                *(u32x2*)(F_xcb + (size_t)tok * 768 + c) = w0; *(u32x2*)(F_xcb + (size_t)(tok + 1) * 768 + c) = w1;
                *(LAS u32x2*)(L + G_XT + tl * GXS + c * 2) = w0; *(LAS u32x2*)(L + G_XT + (tl + 1) * GXS + c * 2) = w1;
                *(LAS u32x2*)(L + G_MT + tl * GXS + c * 2) = xq[pr][gi][3]; *(LAS u32x2*)(L + G_MT + (tl + 1) * GXS + c * 2) = xq[pr][gi][4];
                __builtin_amdgcn_sched_barrier(0);
            }
            { const int sn_ = st + F.gsz < st_end ? st + F.gsz : st; if (pr == 0) G_LOAD1(sn_, 0); else G_LOAD1(sn_, 1); }
            __builtin_amdgcn_sched_barrier(0);
        }
        __syncthreads();
        {
            f32x16 acc = f32x16{};
            LAS const unsigned char* arow = L + (wave < 4 ? G_XT : G_MT) + r32 * GXS + ((wave & 3) * 192 + 8 * hh) * 2;
            LAS const unsigned char* brow = L + G_GT + (r32 < 8 ? r32 : 8) * GTS + (wave * 192 + 8 * hh) * 2;
#pragma unroll
            for (int ks = 0; ks < 12; ++ks)
                acc = __builtin_amdgcn_mfma_f32_32x32x16_bf16(*(LAS const bf16x8*)(arow + ks * 32), *(LAS const bf16x8*)(brow + ks * 32), acc, 0, 0, 0);
            if (r32 < 8) {
#pragma unroll
                for (int i = 0; i < 16; ++i) *(LAS float*)(L + G_RED + ((wave * 32 + (i & 3) + 8 * (i >> 2) + 4 * hh) * 8 + r32) * 4) = acc[i];
            }
        }
        __syncthreads();
        if (F.tid < 256) { const int tk = F.tid >> 3, n = F.tid & 7; float v = bgn;
#pragma unroll
            for (int w = 0; w < 8; ++w) v += *(LAS const float*)(L + G_RED + ((w * 32 + tk) * 8 + n) * 4);
            F_gates[(size_t)(32 * st + tk) * 8 + n] = n < 4 ? v : (fminf(v, 0.f) - log1pf(__expf(-fabsf(v)))); }
    }
#undef G_LOAD
#undef G_LOAD1
}

namespace scan {
using f32x16 = __attribute__((ext_vector_type(16))) float;
typedef float f32x2_t __attribute__((ext_vector_type(2))); typedef __bf16 bf16x2_t __attribute__((ext_vector_type(2)));
typedef short s16x4 __attribute__((ext_vector_type(4)));
#define MFMA32(a, b, c) __builtin_amdgcn_mfma_f32_32x32x16_bf16((a), (b), (c), 0, 0, 0)
__device__ __forceinline__ unsigned cvtpk(float lo, float hi) { f32x2_t v = {lo, hi}; bf16x2_t b = __builtin_convertvector(v, bf16x2_t); return __builtin_bit_cast(unsigned, b); }
template <int S> __device__ __forceinline__ bf16x8 pack_step(const f32x16& x) {
    u32x4 p = {cvtpk(x[8 * S], x[8 * S + 1]), cvtpk(x[8 * S + 2], x[8 * S + 3]), cvtpk(x[8 * S + 4], x[8 * S + 5]), cvtpk(x[8 * S + 6], x[8 * S + 7])};
    return __builtin_bit_cast(bf16x8, p);
}
__device__ __forceinline__ int crow(int reg, int hh) { return (reg & 3) + 8 * (reg >> 2) + 4 * hh; }
__device__ __forceinline__ bf16x8 ld128(LAS const unsigned char* p) { return *(LAS const bf16x8*)p; }
__device__ __forceinline__ bf16x8 ld2x64(LAS const unsigned char* p) { const s16x4 a = *(LAS const s16x4*)p, b = *(LAS const s16x4*)(p + 16); return __builtin_shufflevector(a, b, 0, 1, 2, 3, 4, 5, 6, 7); }
__device__ __forceinline__ float lo_bf(unsigned w) { return __uint_as_float(w << 16); }
__device__ __forceinline__ float hi_bf(unsigned w) { return __uint_as_float(w & 0xffff0000u); }

constexpr int HQS = 528, HTS = 80, HOS = 1040;
constexpr int H_Q = 0, H_K = H_Q + 32 * HQS, H_KT = H_K + 32 * HQS, H_VT = H_KT + 256 * HTS, H_DEC = H_VT + 256 * HTS, H_HT = H_DEC + 1024, H_NW = H_HT + 4096, H_O = H_NW + 512, H_END = H_O + 32 * HOS;
static_assert(H_END <= SCAN_LDS, "hgrn lds");
__device__ __forceinline__ void hgrn_pair_item(Ctx& F, int l, int b, int hp) {
    const int tid0 = F.tid, wave = F.wave;
    LAS unsigned char* L = F.lds;
    if (tid0 < 128) ((LAS float*)(L + H_NW))[tid0] = F_hgrn_norm_w[l * 128 + tid0];
    const size_t row0 = (size_t)b * SEQ;
    const bf16_t* pbase0 = F_proj + row0 * P_IN + hp * 256;
    bf16_t* gbase0 = F_proj + row0 * P_IN + O_HG + hp * 256;
    const int hw = wave >> 2, vs = wave & 3;
    f32x16 S[4];
#pragma unroll
    for (int i = 0; i < 4; ++i) S[i] = f32x16{};
    unsigned rq[8], rf[8], rv[8];
#define HG_LOADRAW(cc) do { const bf16_t* pb_ = pbase0 + 2 * (tid0 & 127) + (size_t)((cc) * 32 + 8 * (tid0 >> 7)) * P_IN; \
        _Pragma("unroll") for (int i = 0; i < 8; ++i) rf[i] = *(const unsigned*)(pb_ + (size_t)i * P_IN + O_HF);     \
        _Pragma("unroll") for (int i = 0; i < 8; ++i) { rq[i] = *(const unsigned*)(pb_ + (size_t)i * P_IN + O_HQ); rv[i] = *(const unsigned*)(pb_ + (size_t)i * P_IN + O_HI); } } while (0)
    HG_LOADRAW(0);
    for (int c = 0; c < SEQ / 32; ++c) {
        int tid = tid0; asm volatile("" : "+v"(tid));
        const int lane = tid & 63, r = lane & 31, hh = lane >> 5, cp = tid & 127, tq = tid >> 7, c0 = 2 * cp;
        const int orow = tid >> 3, ot = orow & 31, oh = orow >> 5, opart = tid & 7;
        bf16_t* gbase = gbase0 + (size_t)ot * P_IN + oh * 128 + 16 * opart;
        const u32x4 g0 = *(const u32x4*)(gbase + (size_t)(c * 32) * P_IN), g1 = *(const u32x4*)(gbase + (size_t)(c * 32) * P_IN + 8);
        float cu0[8], cu1[8]; float cs0 = 0.f, cs1 = 0.f;
#pragma unroll
        for (int i = 0; i < 8; ++i) { cs0 += lo_bf(rf[i]); cu0[i] = cs0; cs1 += hi_bf(rf[i]); cu1[i] = cs1; }
        *(LAS f32x2_t*)(L + H_HT + (tq * 256 + c0) * 4) = (f32x2_t){cs0, cs1};
        __syncthreads();
        {
            float off0 = 0.f, off1 = 0.f, bl0 = 0.f, bl1 = 0.f;
#pragma unroll
            for (int qq = 0; qq < 4; ++qq) { const f32x2_t h = *(LAS const f32x2_t*)(L + H_HT + (qq * 256 + c0) * 4); bl0 += h[0]; bl1 += h[1]; if (qq < tq) { off0 += h[0]; off1 += h[1]; } }
            unsigned kt0[4], kt1[4], vt0[4], vt1[4]; float rp0 = 0.f, rp1 = 0.f;
#pragma unroll
            for (int i = 0; i < 8; ++i) {
                const float bc0 = cu0[i] + off0, bc1 = cu1[i] + off1;
                const float e0 = __builtin_amdgcn_exp2f(bc0 - bl0), e1 = __builtin_amdgcn_exp2f(bc1 - bl1);
                const float r0 = rcp_f(e0), r1 = rcp_f(e1);
                const float f0 = i == 0 ? __builtin_amdgcn_exp2f(lo_bf(rf[0])) : e0 * rp0, f1 = i == 0 ? __builtin_amdgcn_exp2f(hi_bf(rf[0])) : e1 * rp1;
                rp0 = r0; rp1 = r1;
                const float q0 = lo_bf(rq[i]) * e0, q1 = hi_bf(rq[i]) * e1;
                const float k0 = (1.f - f0) * r0, k1 = (1.f - f1) * r1;
                const unsigned kb = cvtpk(k0, k1);
                *(LAS unsigned*)(L + H_Q + (8 * tq + i) * HQS + c0 * 2) = cvtpk(q0, q1);
                *(LAS unsigned*)(L + H_K + (8 * tq + i) * HQS + c0 * 2) = kb;
                if (i & 1) { kt0[i >> 1] |= kb << 16; kt1[i >> 1] |= kb & 0xffff0000u; vt0[i >> 1] |= rv[i] << 16; vt1[i >> 1] |= rv[i] & 0xffff0000u; }
                else { kt0[i >> 1] = kb & 0xffffu; kt1[i >> 1] = kb >> 16; vt0[i >> 1] = rv[i] & 0xffffu; vt1[i >> 1] = rv[i] >> 16; }
            }
            *(LAS u32x4*)(L + H_KT + c0 * HTS + 16 * tq) = (u32x4){kt0[0], kt0[1], kt0[2], kt0[3]};
            *(LAS u32x4*)(L + H_KT + (c0 + 1) * HTS + 16 * tq) = (u32x4){kt1[0], kt1[1], kt1[2], kt1[3]};
            *(LAS u32x4*)(L + H_VT + c0 * HTS + 16 * tq) = (u32x4){vt0[0], vt0[1], vt0[2], vt0[3]};
            *(LAS u32x4*)(L + H_VT + (c0 + 1) * HTS + 16 * tq) = (u32x4){vt1[0], vt1[1], vt1[2], vt1[3]};
            if (tq == 0) *(LAS f32x2_t*)(L + H_DEC + c0 * 4) = (f32x2_t){__builtin_amdgcn_exp2f(bl0), __builtin_amdgcn_exp2f(bl1)};
        }
        { const int cn_ = c + 1 < SEQ / 32 ? c + 1 : SEQ / 32 - 1; HG_LOADRAW(cn_); }
        __syncthreads();
        {
            const int cb = hw * 128;
#pragma unroll
            for (int db = 0; db < 4; ++db)
#pragma unroll
                for (int g = 0; g < 4; ++g) { const f32x4 dv = *(LAS const f32x4*)(L + H_DEC + (cb + 32 * db + 8 * g + 4 * hh) * 4);
#pragma unroll
                    for (int i = 0; i < 4; ++i) S[db][4 * g + i] *= dv[i]; }
#define SB() __builtin_amdgcn_sched_barrier(0)
            LAS const unsigned char* qrow = L + H_Q + r * HQS + cb * 2;
            LAS const unsigned char* krow = L + H_K + r * HQS + cb * 2;
            LAS const unsigned char* vrow = L + H_VT + (cb + 32 * vs + r) * HTS;
            bf16x8 pa0, pa1;
            { f32x16 x1 = f32x16{};
              bf16x8 fa0 = ld128(krow + (8 * hh) * 2), fb0 = ld128(qrow + (8 * hh) * 2), fa1 = ld128(krow + (16 + 8 * hh) * 2), fb1 = ld128(qrow + (16 + 8 * hh) * 2); SB();
#pragma unroll
              for (int ks = 0; ks < 8; ks += 2) {
                  x1 = MFMA32(fa0, fb0, x1); if (ks + 2 < 8) { fa0 = ld128(krow + (16 * (ks + 2) + 8 * hh) * 2); fb0 = ld128(qrow + (16 * (ks + 2) + 8 * hh) * 2); } SB();
                  x1 = MFMA32(fa1, fb1, x1); if (ks + 3 < 8) { fa1 = ld128(krow + (16 * (ks + 3) + 8 * hh) * 2); fb1 = ld128(qrow + (16 * (ks + 3) + 8 * hh) * 2); } SB();
              }
#pragma unroll
              for (int i = 0; i < 16; ++i) x1[i] = (crow(i, hh) <= r) ? x1[i] : 0.f;
              pa0 = pack_step<0>(x1); pa1 = pack_step<1>(x1); }
            f32x16 o = f32x16{};
            { bf16x8 v0 = ld2x64(vrow + (4 * hh) * 2), v1 = ld2x64(vrow + (16 + 4 * hh) * 2);
              bf16x8 q0 = ld2x64(qrow + (4 * hh) * 2), q1 = ld2x64(qrow + (16 + 4 * hh) * 2); SB();
              o = MFMA32(pa0, v0, o); SB();
              o = MFMA32(pa1, v1, o); SB();
#pragma unroll
              for (int db = 0; db < 4; ++db) {
                  o = MFMA32(q0, pack_step<0>(S[db]), o); if (db + 1 < 4) q0 = ld2x64(qrow + (32 * (db + 1) + 4 * hh) * 2); SB();
                  o = MFMA32(q1, pack_step<1>(S[db]), o); if (db + 1 < 4) q1 = ld2x64(qrow + (32 * (db + 1) + 16 + 4 * hh) * 2); SB();
              } }
            { const bf16x8 vb0 = ld128(vrow + (8 * hh) * 2), vb1 = ld128(vrow + (16 + 8 * hh) * 2);
              LAS const unsigned char* ktr = L + H_KT + (cb + r) * HTS;
              bf16x8 k0 = ld128(ktr + (8 * hh) * 2), k1 = ld128(ktr + (16 + 8 * hh) * 2); SB();
#pragma unroll
              for (int db = 0; db < 4; ++db) {
                  S[db] = MFMA32(k0, vb0, S[db]); if (db + 1 < 4) k0 = ld128(ktr + 32 * (db + 1) * HTS + (8 * hh) * 2); SB();
                  S[db] = MFMA32(k1, vb1, S[db]); if (db + 1 < 4) k1 = ld128(ktr + 32 * (db + 1) * HTS + (16 + 8 * hh) * 2); SB();
              } }
#undef SB
#pragma unroll
            for (int i = 0; i < 16; ++i) *(LAS float*)(L + H_O + crow(i, hh) * HOS + (cb + 32 * vs + r) * 4) = o[i];
        }
        __syncthreads();
        {
            f32x4 ov[4]; float ss = 0.f;
#pragma unroll
            for (int j = 0; j < 4; ++j) { ov[j] = *(LAS const f32x4*)(L + H_O + ot * HOS + (oh * 128 + 16 * opart + 4 * j) * 4); ss += (ov[j][0] * ov[j][0] + ov[j][1] * ov[j][1]) + (ov[j][2] * ov[j][2] + ov[j][3] * ov[j][3]); }
            ss += swz_xor<1>(ss); ss += swz_xor<2>(ss); ss += swz_xor<4>(ss);
            const float rs = rsqrtf(ss * (1.0f / 128.0f) + EPS);
            unsigned gw[8] = {g0[0], g0[1], g0[2], g0[3], g1[0], g1[1], g1[2], g1[3]}; unsigned ow[8];
#pragma unroll
            for (int j = 0; j < 4; ++j) { const f32x4 nwv = *(LAS const f32x4*)(L + H_NW + (16 * opart + 4 * j) * 4);
                const float ga = lo_bf(gw[2 * j]), gb = hi_bf(gw[2 * j]), gc = lo_bf(gw[2 * j + 1]), gd = hi_bf(gw[2 * j + 1]);
                ow[2 * j] = cvtpk(ov[j][0] * rs * nwv[0] * ga, ov[j][1] * rs * nwv[1] * gb);
                ow[2 * j + 1] = cvtpk(ov[j][2] * rs * nwv[2] * gc, ov[j][3] * rs * nwv[3] * gd); }
            bf16_t* gp = gbase + (size_t)(c * 32) * P_IN;
            *(u32x4*)gp = (u32x4){ow[0], ow[1], ow[2], ow[3]}; *(u32x4*)(gp + 8) = (u32x4){ow[4], ow[5], ow[6], ow[7]};
        }
    }
#undef HG_LOADRAW
}

constexpr int MQS = 400, MVS = 448, MHS = 912, MRS = 384;
constexpr int M_Q = 0, M_K = M_Q + 32 * MQS, M_V = M_K + 32 * MQS, M_H = M_V + 32 * MVS, M_W = M_H + 32 * MHS,
              M_WK = M_W, M_WV = M_WK + 768 * 4, M_NW = M_WV + 768 * 4, M_SK = M_NW + 768, M_SC = M_SK + 768, M_RAW = M_SC + 1024 + 256, M_PA = M_RAW + 2 * 2 * 32 * MRS, M_END = M_PA + 2048 + 16;
static_assert(M_END <= SCAN_LDS, "mlstm lds");
typedef short v4i16_t __attribute__((ext_vector_type(4)));
__device__ __forceinline__ s16x4 trd(LAS const unsigned char* p) { return __builtin_bit_cast(s16x4, __builtin_amdgcn_ds_read_tr16_b64_v4i16((LAS v4i16_t*)p)); }
__device__ __forceinline__ bf16x8 trd2(LAS const unsigned char* p, int rowstep4) { const s16x4 a = trd(p), b = trd(p + rowstep4); return __builtin_shufflevector(a, b, 0, 1, 2, 3, 4, 5, 6, 7); }
__device__ __forceinline__ void mlstm_item(Ctx& F, int l, int b, int h) {
    const int tid0 = F.tid, wave = F.wave;
    LAS unsigned char* L = F.lds;
    const size_t row0 = (size_t)b * SEQ;
    { const int tid = tid0;
#pragma unroll 1
    for (int i = tid; i < 768; i += 512) { const int g_ = i >> 4, ii_ = (i >> 2) & 3, o_ = i & 3, dst = (ii_ * 48 + g_) * 4 + o_;
        const float* wk_ = F_wk + (l * 192 + h * 48 + g_) * 16 + ii_ * 4; const float* wq_ = F_wq + (l * 192 + h * 48 + g_) * 16 + o_ * 4;
        ((LAS float*)(L + M_WK))[dst] = (wk_[0] * wq_[0] + wk_[1] * wq_[1]) + (wk_[2] * wq_[2] + wk_[3] * wq_[3]);
        ((LAS float*)(L + M_WV))[dst] = F_wv[(l * 192 + h * 48) * 16 + i]; }
    if (tid < 192) { ((LAS float*)(L + M_NW))[tid] = F_ml_norm_w[l * 768 + h * 192 + tid]; ((LAS float*)(L + M_SK))[tid] = F_ml_skip[l * 768 + h * 192 + tid]; }
    if (tid == 0) *(LAS int*)(L + M_PA + 2048) = 0;
    { const int row = tid >> 4, cw_ = tid & 15; ((LAS unsigned*)(L + M_V + row * MVS + 384))[cw_] = cw_ == 0 ? 0x00003f80u : 0u; }
    }
    bf16_t* zbase0 = F_proj + row0 * P_IN + O_MZ + h * 192;
    float Bprev = 0.f, Mprev = -1e30f; float gi = 0.f, gf = 0.f;
    const float* gatep0 = F_gates + row0 * 8 + h;
    f32x16 C[6];
#pragma unroll
    for (int i = 0; i < 6; ++i) C[i] = f32x16{};
    u32x4 xr[3];
    const bf16_t* xhead = F_proj + row0 * P_IN + O_MX + h * 192; const bf16_t* chead = F_xcb + row0 * 768 + h * 192;
#define ML_LOADRAW(cc) do { _Pragma("unroll") for (int k = 0; k < 3; ++k) { const int p_ = tid0 + 512 * k; const int q_ = p_ % 768, rw_ = q_ / 24, cl_ = q_ % 24; const size_t tg = (size_t)(cc) * 32 + rw_; \
        xr[k] = p_ < 768 ? *(const u32x4*)(chead + tg * 768 + 8 * cl_) : *(const u32x4*)(xhead + tg * P_IN + 8 * cl_); } } while (0)
#define ML_STORERAW(cc) do { _Pragma("unroll") for (int k = 0; k < 3; ++k) { const int p_ = tid0 + 512 * k; *(LAS u32x4*)(L + M_RAW + ((cc) & 1) * 2 * 32 * MRS + p_ * 16) = xr[k]; } } while (0)
#define ML_LOADG(cc) do { const float* gp_ = gatep0 + (size_t)(tid0 & 31) * 8; gi = gp_[(size_t)(cc) * 32 * 8]; gf = gp_[(size_t)(cc) * 32 * 8 + 4]; } while (0)
#define ML_DPP(v, ctrl) __builtin_bit_cast(float, __builtin_amdgcn_update_dpp(0, __builtin_bit_cast(int, (v)), (ctrl), 0xF, 0xF, true))
#define ML_SCALARS(cc) do { const int r = tid0 & 31, hh = (tid0 >> 5) & 1, lane = tid0 & 63; LAS float* sc_ = (LAS float*)(L + M_SC) + ((cc) & 1) * 128; \
        float v_ = gf; \
        v_ += ML_DPP(v_, 0x111); v_ += ML_DPP(v_, 0x112); v_ += ML_DPP(v_, 0x114); v_ += ML_DPP(v_, 0x118); \
        v_ += __builtin_bit_cast(float, __builtin_amdgcn_update_dpp(0, __builtin_bit_cast(int, v_), 0x142, 0xA, 0xF, false)); \
        const float Bt_ = Bprev + v_; \
        const float Bl_ = Bprev + __builtin_bit_cast(float, __builtin_amdgcn_readlane(__builtin_bit_cast(int, v_), 31)); \
        const float a_ = gi - Bt_; float m_ = a_; \
        m_ = fmaxf(m_, ML_DPP(m_, 0xB1)); m_ = fmaxf(m_, ML_DPP(m_, 0x4E)); m_ = fmaxf(m_, ML_DPP(m_, 0x141)); m_ = fmaxf(m_, ML_DPP(m_, 0x140)); \
        const float mx_ = fmaxf(__builtin_bit_cast(float, __builtin_amdgcn_readlane(__builtin_bit_cast(int, m_), 0)), __builtin_bit_cast(float, __builtin_amdgcn_readlane(__builtin_bit_cast(int, m_), 16))); \
        const float ML_ = fmaxf(Mprev, mx_); \
        if (hh == 0) { sc_[r] = __expf(a_ - ML_); sc_[32 + r] = __expf(-Bt_ - ML_); } if (lane == 0) sc_[64] = __expf(Mprev - ML_); \
        Bprev = Bl_; Mprev = ML_; } while (0)
    ML_LOADRAW(0); ML_STORERAW(0); ML_LOADRAW(1);
    if (wave == 7) { ML_LOADG(0); ML_SCALARS(0); ML_LOADG(1); }
    __syncthreads();
    for (int c = 0; c < SEQ / 32; ++c) {
        int tid = tid0; asm volatile("" : "+v"(tid));
        const int lane = tid & 63, r = lane & 31, hh = lane >> 5, g = tid % 48, tsl = tid / 48, ot = tid >> 4, opart = tid & 15;
        bf16_t* zbase = zbase0 + (size_t)ot * P_IN + 12 * opart;
        u32x2 zr[3];
#pragma unroll
        for (int j = 0; j < 3; ++j) zr[j] = *(const u32x2*)(zbase + (size_t)(c * 32) * P_IN + 4 * j);
        const float* gpn_ = gatep0 + (size_t)(tid0 & 31) * 8 + (size_t)(c + 2 < SEQ / 32 ? c + 2 : SEQ / 32 - 1) * 32 * 8;
        const float gin = gpn_[0], gfn = gpn_[4];
        if (tid < 384) {
            LAS const float* sc = (LAS const float*)(L + M_SC) + (c & 1) * 128;
            f32x4 wk[4], wv[4];
#pragma unroll
            for (int i = 0; i < 4; ++i) { wk[i] = *(LAS const f32x4*)(L + M_WK + (i * 48 + g) * 16); wv[i] = *(LAS const f32x4*)(L + M_WV + (i * 48 + g) * 16); }
#pragma unroll
            for (int a = 0; a < 4; ++a) {
                const int t = 4 * tsl + a;
                LAS const unsigned char* raw = L + M_RAW + (c & 1) * 2 * 32 * MRS + t * MRS + 8 * g;
                const u32x2 xcw = *(LAS const u32x2*)raw, mxw = *(LAS const u32x2*)(raw + 32 * MRS);
                const float xcv[4] = {lo_bf(xcw[0]), hi_bf(xcw[0]), lo_bf(xcw[1]), hi_bf(xcw[1])}, xl[4] = {lo_bf(mxw[0]), hi_bf(mxw[0]), lo_bf(mxw[1]), hi_bf(mxw[1])};
                float kt[4], vv[4];
#pragma unroll
                for (int i = 0; i < 4; ++i)
#pragma unroll
                    for (int o = 0; o < 4; ++o) { if (i == 0) { kt[o] = xcv[0] * wk[0][o]; vv[o] = xl[0] * wv[0][o]; } else { kt[o] += xcv[i] * wk[i][o]; vv[o] += xl[i] * wv[i][o]; } }
                const float kw = 0.07216878364870323f * sc[t];
#pragma unroll
                for (int o = 0; o < 4; ++o) kt[o] *= kw;
                *(LAS u32x2*)(L + M_Q + t * MQS + 8 * g) = xcw;
                *(LAS u32x2*)(L + M_K + t * MQS + 8 * g) = (u32x2){cvtpk(kt[0], kt[1]), cvtpk(kt[2], kt[3])};
                *(LAS u32x2*)(L + M_V + t * MVS + 8 * g) = (u32x2){cvtpk(vv[0], vv[1]), cvtpk(vv[2], vv[3])};
            }
        }
        __syncthreads();
#define SB() __builtin_amdgcn_sched_barrier(0)
        if (wave < 7) {
            const float decc = ((LAS const float*)(L + M_SC))[(c & 1) * 128 + 64];
#pragma unroll
            for (int db = 0; db < 6; ++db) C[db] *= decc;
            LAS const unsigned char* qrow = L + M_Q + r * MQS;
            const int i16 = lane & 15, tq_ = i16 >> 2, tp_ = i16 & 3, g1_ = (lane >> 4) & 1;
            LAS const unsigned char* vtr = L + M_V + tq_ * MVS + (32 * wave + 16 * g1_ + 4 * tp_) * 2;
            LAS const unsigned char* ktr = L + M_K + tq_ * MQS + (16 * g1_ + 4 * tp_) * 2;
            f32x16 X = f32x16{};
            {
                bf16x8 q0 = ld2x64(qrow + (4 * hh) * 2), q1 = ld2x64(qrow + (16 + 4 * hh) * 2); SB();
#pragma unroll
                for (int db = 0; db < 6; ++db) {
                    X = MFMA32(q0, pack_step<0>(C[db]), X); if (db + 1 < 6) q0 = ld2x64(qrow + (32 * (db + 1) + 4 * hh) * 2); SB();
                    X = MFMA32(q1, pack_step<1>(C[db]), X); if (db + 1 < 6) q1 = ld2x64(qrow + (32 * (db + 1) + 16 + 4 * hh) * 2); SB();
                }
            }
            {
                const bf16x8 vb0 = trd2(vtr + (8 * hh) * MVS, 4 * MVS), vb1 = trd2(vtr + (16 + 8 * hh) * MVS, 4 * MVS);
                bf16x8 k0 = trd2(ktr + (8 * hh) * MQS, 4 * MQS), k1 = trd2(ktr + (16 + 8 * hh) * MQS, 4 * MQS); SB();
#pragma unroll
                for (int db = 0; db < 6; ++db) {
                    C[db] = MFMA32(k0, vb0, C[db]); if (db + 1 < 6) k0 = trd2(ktr + (8 * hh) * MQS + 64 * (db + 1), 4 * MQS); SB();
                    C[db] = MFMA32(k1, vb1, C[db]); if (db + 1 < 6) k1 = trd2(ktr + (16 + 8 * hh) * MQS + 64 * (db + 1), 4 * MQS); SB();
                }
            }
            {
                const bf16x8 v0 = trd2(vtr + (4 * hh) * MVS, 8 * MVS), v1 = trd2(vtr + (16 + 4 * hh) * MVS, 8 * MVS);
                while (*(volatile LAS int*)(L + M_PA + 2048) != c + 1) __builtin_amdgcn_s_sleep(1);
                asm volatile("" ::: "memory");
                const bf16x8 pa0 = *(LAS const bf16x8*)(L + M_PA + lane * 16), pa1 = *(LAS const bf16x8*)(L + M_PA + 1024 + lane * 16); SB();
                X = MFMA32(pa0, v0, X);
                X = MFMA32(pa1, v1, X);
            }
#pragma unroll
            for (int i = 0; i < 16; ++i) *(LAS float*)(L + M_H + crow(i, hh) * MHS + (32 * wave + r) * 4) = X[i];
        } else {
            LAS const unsigned char* qrow = L + M_Q + r * MQS;
            LAS const unsigned char* krow = L + M_K + r * MQS;
            f32x16 x1 = f32x16{};
            bf16x8 fa0 = ld128(krow + (8 * hh) * 2), fb0 = ld128(qrow + (8 * hh) * 2), fa1 = ld128(krow + (16 + 8 * hh) * 2), fb1 = ld128(qrow + (16 + 8 * hh) * 2); SB();
#pragma unroll
            for (int ks = 0; ks < 12; ks += 2) {
                x1 = MFMA32(fa0, fb0, x1); if (ks + 2 < 12) { fa0 = ld128(krow + (16 * (ks + 2) + 8 * hh) * 2); fb0 = ld128(qrow + (16 * (ks + 2) + 8 * hh) * 2); } SB();
                x1 = MFMA32(fa1, fb1, x1); if (ks + 3 < 12) { fa1 = ld128(krow + (16 * (ks + 3) + 8 * hh) * 2); fb1 = ld128(qrow + (16 * (ks + 3) + 8 * hh) * 2); } SB();
            }
#pragma unroll
            for (int i = 0; i < 16; ++i) x1[i] = (crow(i, hh) <= r) ? x1[i] : 0.f;
            *(LAS bf16x8*)(L + M_PA + lane * 16) = pack_step<0>(x1); *(LAS bf16x8*)(L + M_PA + 1024 + lane * 16) = pack_step<1>(x1);
            asm volatile("s_waitcnt lgkmcnt(0)" ::: "memory");
            if (lane == 0) *(volatile LAS int*)(L + M_PA + 2048) = c + 1;
            if (c + 1 < SEQ / 32) { ML_SCALARS(c + 1); }
        }
#undef SB
        { ML_STORERAW(c + 1); const int cn_ = c + 2 < SEQ / 32 ? c + 2 : SEQ / 32 - 1; ML_LOADRAW(cn_); }
        __syncthreads();
        {
            const float Y = *(LAS const float*)(L + M_H + ot * MHS + 192 * 4), eb = ((LAS const float*)(L + M_SC))[(c & 1) * 128 + 32 + ot];
            const float idn = rcp_f(fmaxf(fabsf(Y), eb));
            float hv[12]; float s1 = 0.f;
#pragma unroll
            for (int j = 0; j < 3; ++j) { const f32x4 v = *(LAS const f32x4*)(L + M_H + ot * MHS + (12 * opart + 4 * j) * 4);
#pragma unroll
                for (int i = 0; i < 4; ++i) { hv[4 * j + i] = v[i] * idn; s1 += hv[4 * j + i]; } }
            s1 += swz_xor<1>(s1); s1 += swz_xor<2>(s1); s1 += swz_xor<4>(s1); s1 += swz_xor<8>(s1);
            const float mean = s1 * (1.0f / 192.0f); float s2 = 0.f;
#pragma unroll
            for (int i = 0; i < 12; ++i) { hv[i] -= mean; s2 += hv[i] * hv[i]; }
            s2 += swz_xor<1>(s2); s2 += swz_xor<2>(s2); s2 += swz_xor<4>(s2); s2 += swz_xor<8>(s2);
            const float rs = rsqrtf(s2 * (1.0f / 192.0f) + EPS);
            u32x2 ow[3];
#pragma unroll
            for (int j = 0; j < 3; ++j) { const f32x4 nwv = *(LAS const f32x4*)(L + M_NW + (12 * opart + 4 * j) * 4), skv = *(LAS const f32x4*)(L + M_SK + (12 * opart + 4 * j) * 4);
                const u32x2 xw = *(LAS const u32x2*)(L + M_RAW + (c & 1) * 2 * 32 * MRS + ot * MRS + (12 * opart + 4 * j) * 2);
                const float x0 = lo_bf(xw[0]), x1v = hi_bf(xw[0]), x2 = lo_bf(xw[1]), x3 = hi_bf(xw[1]);
                const float z0 = lo_bf(zr[j][0]), z1 = hi_bf(zr[j][0]), z2 = lo_bf(zr[j][1]), z3 = hi_bf(zr[j][1]);
                ow[j][0] = cvtpk((hv[4 * j] * rs * nwv[0] + skv[0] * x0) * z0, (hv[4 * j + 1] * rs * nwv[1] + skv[1] * x1v) * z1);
                ow[j][1] = cvtpk((hv[4 * j + 2] * rs * nwv[2] + skv[2] * x2) * z2, (hv[4 * j + 3] * rs * nwv[3] + skv[3] * x3) * z3); }
            bf16_t* zp = zbase + (size_t)(c * 32) * P_IN;
#pragma unroll
            for (int j = 0; j < 3; ++j) *(u32x2*)(zp + 4 * j) = ow[j];
        }
        gi = gin; gf = gfn;
    }
#undef ML_LOADRAW
#undef ML_STORERAW
#undef ML_DPP
#undef ML_LOADG
#undef ML_SCALARS
}
#undef MFMA32
}

__device__ __forceinline__ void phase_mixers(Ctx& F, int l) {
    const int bpg = BATCH / F.ngrp, b0 = F.grp * bpg, N_ML = bpg * 4, N_HG = bpg * 3, N_XA = bpg * 4 * (SEQ / 256);
    unsigned* qbase = F_ctl + CW_QUEUE + ((l * 3) * 8 + F.grp) * 32;
    volatile LAS int* nxt = (volatile LAS int*)(F.lds + MISC_OFF);
    {
        unsigned* ctr = qbase;
        for (;;) {
            __syncthreads();
            if (F.tid == 0) *nxt = (int)atomicAdd(ctr, 1u);
            __syncthreads();
            const int it = __builtin_amdgcn_readfirstlane(*nxt);
            if (it >= N_ML) break;
            scan::mlstm_item(F, l, b0 + (it >> 2), it & 3);
        }
    }
    {
        unsigned* ctr = qbase + 8 * 32;
        for (;;) {
            __syncthreads();
            if (F.tid == 0) *nxt = (int)atomicAdd(ctr, 1u);
            __syncthreads();
            const int it = __builtin_amdgcn_readfirstlane(*nxt);
            if (it >= N_HG) break;
            scan::hgrn_pair_item(F, l, b0 + it / 3, it % 3);
        }
    }
    {
        unsigned* ctr = qbase + 16 * 32;
        for (;;) {
            __syncthreads();
            if (F.tid == 0) *nxt = (int)atomicAdd(ctr, 1u);
            __syncthreads();
            const int u = __builtin_amdgcn_readfirstlane(*nxt);
            if (u >= N_XA) break;
            const int qp = u & 7, h = (u >> 3) & 3, b = b0 + (u >> 5);
            const size_t qrow = (size_t)b * SEQ + qp * 256;
            const bf16_t* Kh = F_mkv + (size_t)(b * MEM_LEN) * 2048 + l * 1024 + h * 128;
            xattn::attn_unit<1>((const xattn::bf16*)(F_proj + qrow * P_IN + O_AQ + h * 128), (const xattn::bf16*)Kh, (const xattn::bf16*)(Kh + 512),
                                F_proj + qrow * P_IN + O_AZ + h * 128, F_xa_norm_w + l * 128, (char*)(unsigned char*)F.lds);
        }
    }
}

__device__ __forceinline__ void phase_final(Ctx& F) {
    u32x2 v[4][4], vn[4][4]; float sv[4], svn[4];
#define FIN_LOAD(dst, sdst, rb_) do { _Pragma("unroll") for (int q = 0; q < 4; ++q) { \
        _Pragma("unroll") for (int j = 0; j < 4; ++j) dst[q][j] = ((const u32x2*)(F_xb + (size_t)((rb_) + q) * D_MODEL) + F.lane)[64 * j]; sdst[q] = F_ss2[(rb_) + q]; } } while (0)
    f32x4 wv[4];
#pragma unroll
    for (int j = 0; j < 4; ++j) wv[j] = ((const f32x4*)F_final_w + F.lane)[64 * j];
    const int rend = (F.grp + 1) * (M_TOK / F.ngrp), rstep = F.gsz * 8 * 4;
    int rb = F.grp * (M_TOK / F.ngrp) + (F.gj * 8 + F.wave) * 4;
    if (rb < rend) FIN_LOAD(v, sv, rb);
    for (; rb < rend; rb += rstep) {
        const int rbn = rb + rstep < rend ? rb + rstep : rb;
        FIN_LOAD(vn, svn, rbn);
#pragma unroll
        for (int q = 0; q < 4; ++q) { const float rs = rsqrtf(sv[q] * (1.0f / 1024.0f) + EPS);
            f32x4* p = (f32x4*)(F.out + (size_t)(rb + q) * D_MODEL) + F.lane;
#pragma unroll
            for (int j = 0; j < 4; ++j) { const f32x4 x = {__uint_as_float(v[q][j].x << 16), __uint_as_float(v[q][j].x & 0xffff0000u), __uint_as_float(v[q][j].y << 16), __uint_as_float(v[q][j].y & 0xffff0000u)};
                p[64 * j] = x * rs * wv[j]; } }
#pragma unroll
        for (int q = 0; q < 4; ++q) { sv[q] = svn[q];
#pragma unroll
            for (int j = 0; j < 4; ++j) v[q][j] = vn[q][j]; }
    }
#undef FIN_LOAD
}

constexpr int N_PHASES = 10;
__global__ void __launch_bounds__(512, 2) fwd_kernel(Params P) {
    extern __shared__ __attribute__((aligned(16))) unsigned char lds_raw[];
    Ctx F;
    F.lds = (LAS unsigned char*)lds_raw; F.tid = threadIdx.x; F.lane = F.tid & 63; F.wave = __builtin_amdgcn_readfirstlane(F.tid >> 6); F.G = gridDim.x;
    F.inp = P.in; F.out = P.out; F.ws = P.ws;
    F.ngrp = (F.G == 256) ? 8 : 1; F.gsz = F.G / F.ngrp; F.grp = (int)blockIdx.x % F.ngrp; F.gj = (int)blockIdx.x / F.ngrp; F.coloc = 0;
    const int lo = P.ph_lo, hi = P.ph_hi;
#define IN(k) (lo <= (k) && (k) < hi)
#if MK_SINGLE
    volatile LAS unsigned* bar_st = (volatile LAS unsigned*)(F.lds + MISC_OFF + 64);
    if (threadIdx.x < 2) bar_st[threadIdx.x] = 0u;
    __syncthreads();
    const XcdBarrier gbar = xcd_barrier_post(F_ctl + CW_BAR, bar_st);
#define SEAM(k) do { if (IN(k) && IN((k) + 1)) { if ((k) == 0) xcd_barrier(gbar); else group_barrier(F_ctl + CW_GBAR + 64 * F.grp, F_ctl + CW_GBAR + 64 * F.grp + 32, (unsigned)(k) + 1u, (unsigned)F.gsz, F_ctl + CW_BAR + XB_TMO, F.coloc); } } while (0)
#else
#define SEAM(k) do { } while (0)
#endif
    if (F.tid == 0) F_ctl[CW_XCC + blockIdx.x] = xb_xcc_id() + 1u;
    if (IN(0)) { phase_prep(F); }
    SEAM(0);
    if (F.ngrp > 1) {
        volatile LAS int* cl = (volatile LAS int*)(F.lds + MISC_OFF + 16);
        if (F.tid == 0) { const unsigned mine = __hip_atomic_load(F_ctl + CW_XCC + blockIdx.x, __ATOMIC_RELAXED, __HIP_MEMORY_SCOPE_AGENT); int same = 1;
            for (int j = 0; j < F.gsz; ++j) same &= (__hip_atomic_load(F_ctl + CW_XCC + j * F.ngrp + F.grp, __ATOMIC_RELAXED, __HIP_MEMORY_SCOPE_AGENT) == mine) ? 1 : 0;
            *cl = same; }
        __syncthreads();
        F.coloc = __builtin_amdgcn_readfirstlane(*cl);
    }
    if (IN(0)) { phase_rows(F);
        if (IN(1)) group_barrier(F_ctl + CW_GBAR + 64 * F.grp, F_ctl + CW_GBAR + 64 * F.grp + 32, 1u, (unsigned)F.gsz, F_ctl + CW_BAR + XB_TMO, F.coloc); }
    if (IN(1)) {
        { pg8::Gemm g{F_memb, F_WkvT, M_MEM, 2048, D_MODEL, D_MODEL}; pg8::GroupRowsOrder S; S.init(M_MEM, 2048, F.G, (int)blockIdx.x, F.ngrp);
          pg8::EpiScaleBf16 E{F_mkv, 2048, F_ssm};
          pg8::gemm_phase<pg8::EpiScaleBf16, pg8::GroupRowsOrder, true, true>(F.lds, g, S, E); }
        { pg8::Gemm g{F_xb, F_WinT, M_TOK, P_IN, D_MODEL, D_MODEL}; pg8::StaticOrder S; S.init(M_TOK, P_IN, F.G, (int)blockIdx.x);
          pg8::EpiProj E{F_proj, F_ss0, F_lb};
          pg8::gemm_phase<pg8::EpiProj, pg8::StaticOrder, true, true>(F.lds, g, S, E); }
    }
    SEAM(1);
    if (IN(2)) phase_gates(F, 0);
    SEAM(2);
    if (IN(3)) phase_mixers(F, 0);
    SEAM(3);
    if (IN(4)) { pg8::Gemm g{F_proj, F_WoutT, M_TOK, D_MODEL, D_MIX, P_IN}; pg8::StaticOrder S; S.init(M_TOK, D_MODEL, F.G, (int)blockIdx.x);
        pg8::EpiResid<true> E{F_x, F.out, F_xb, F_ss1};
        pg8::gemm_phase<pg8::EpiResid<true>, pg8::StaticOrder, true, true>(F.lds, g, S, E); }
    SEAM(4);
    if (IN(5)) { pg8::Gemm g{F_xb, F_WinT + (size_t)P_IN * D_MODEL, M_TOK, P_IN, D_MODEL, D_MODEL}; pg8::StaticOrder S; S.init(M_TOK, P_IN, F.G, (int)blockIdx.x);
        pg8::EpiProj E{F_proj, F_ss1, F_lb + 768};
        pg8::gemm_phase<pg8::EpiProj, pg8::StaticOrder, true, true>(F.lds, g, S, E); }
    SEAM(5);
    if (IN(6)) phase_gates(F, 1);
    SEAM(6);
    if (IN(7)) phase_mixers(F, 1);
    SEAM(7);
    if (IN(8)) { pg8::Gemm g{F_proj, F_WoutT + (size_t)D_MODEL * D_MIX, M_TOK, D_MODEL, D_MIX, P_IN}; pg8::StaticOrder S; S.init(M_TOK, D_MODEL, F.G, (int)blockIdx.x);
        pg8::EpiResid<false> E{F.out, F.out, F_xb, F_ss2};
        pg8::gemm_phase<pg8::EpiResid<false>, pg8::StaticOrder, true, true>(F.lds, g, S, E); }
    SEAM(8);
    if (IN(9)) phase_final(F);
#undef IN
#undef SEAM
}

extern "C" void kernel_launch(void* const* d_in, const int* in_sizes, int n_in, void* d_out, int out_size, void* d_ws, size_t ws_size, hipStream_t stream) {
    static int grid = 0;
    if (grid == 0) {
        if (n_in != 20 || in_sizes[0] != M_TOK * D_MODEL || out_size != M_TOK * D_MODEL || ws_size < WS_END) {
            fprintf(stderr, "kernel_launch: unexpected shapes: n_in %d in0 %d out %d ws %zu (need >= %zu)\n", n_in, n_in > 0 ? in_sizes[0] : -1, out_size, ws_size, (size_t)WS_END); grid = -1; return; }
        int dev = 0, cus = 0, per_cu = 0;
        if (hipGetDevice(&dev) != hipSuccess || hipDeviceGetAttribute(&cus, hipDeviceAttributeMultiprocessorCount, dev) != hipSuccess) { fprintf(stderr, "kernel_launch: device query failed\n"); grid = -1; return; }
        if (hipFuncSetAttribute((const void*)fwd_kernel, hipFuncAttributeMaxDynamicSharedMemorySize, LDS_BYTES) != hipSuccess) { fprintf(stderr, "kernel_launch: hipFuncSetAttribute failed\n"); grid = -1; return; }
        if (hipOccupancyMaxActiveBlocksPerMultiprocessor(&per_cu, (const void*)fwd_kernel, 512, LDS_BYTES) != hipSuccess || per_cu < 1) { fprintf(stderr, "kernel_launch: occupancy query says %d\n", per_cu); per_cu = 1; }
        (void)hipGetLastError();
        grid = cus;
        fprintf(stderr, "kernel_launch: grid %d (cus %d, occupancy %d/CU)\n", grid, cus, per_cu);
    }
    if (grid < 0) return;
    hipMemsetAsync((char*)d_ws + WS_CTL, 0, CTL_ZERO_BYTES, stream);
    Params p{};
    for (int i = 0; i < 20; ++i) p.in[i] = (const float*)d_in[i];
    p.out = (float*)d_out; p.ws = (unsigned char*)d_ws;
#if MK_SINGLE
    p.ph_lo = 0; p.ph_hi = N_PHASES;
    hipLaunchKernelGGL(fwd_kernel, dim3(grid), dim3(512), LDS_BYTES, stream, p);
    { const hipError_t le = hipPeekAtLastError(); if (le != hipSuccess) fprintf(stderr, "kernel_launch: launch failed: %s\n", hipGetErrorName(le)); }
#else
    for (int ph = 0; ph < N_PHASES; ++ph) {
        p.ph_lo = ph; p.ph_hi = ph + 1;
        hipLaunchKernelGGL(fwd_kernel, dim3(grid), dim3(512), LDS_BYTES, stream, p);
    }
    const hipError_t le = hipPeekAtLastError();
    if (le != hipSuccess) fprintf(stderr, "kernel_launch: launch failed: %s\n", hipGetErrorName(le));
#endif
}
```
